# Optimizing an MI355X kernel written in HIP

```python
import math
import jax, jax.numpy as jnp
from jax import lax
import numpy as np

D_MODEL = 4096
BATCH = 4
SEQ = 2048
DEPTH = 1

GRID_W = 64
CTX_LEN = 256
HEAD_DIM = 128
D_ATT = D_MODEL // 2
N_Q_HEADS = D_ATT // HEAD_DIM
N_KV_HEADS = N_Q_HEADS // 4
Q_PER_KV = N_Q_HEADS // N_KV_HEADS
D_KV = N_KV_HEADS * HEAD_DIM
D_LRU = D_MODEL // 2
LRU_BLOCKS = 16
LRU_BLOCK_DIM = D_LRU // LRU_BLOCKS
CONV_WIDTH = 4
CONV_PAD = (2, 1)
LRU_C = 8.0
ROPE_THETA = 10000.0
Q_BLOCK = 128
D_MIX = D_ATT + D_LRU
D_IN = D_ATT + 2 * D_KV + D_ATT + D_LRU + D_LRU
SPLITS = (D_ATT, D_ATT + D_KV, D_ATT + 2 * D_KV, 2 * D_ATT + 2 * D_KV, 2 * D_ATT + 2 * D_KV + D_LRU)
EPS = 1e-6

kernel_name = "hymba_rglru_gqa_dit_layer"


def rmsnorm(x, w):
    xf = x.astype(jnp.float32)
    y = xf * lax.rsqrt(jnp.mean(xf * xf, axis=-1, keepdims=True) + EPS)
    return (y * w.astype(jnp.float32)).astype(x.dtype)


def rope_tables(n_tokens):
    rows = n_tokens // GRID_W
    row = jnp.repeat(jnp.arange(rows), GRID_W).astype(jnp.float32)
    col = jnp.tile(jnp.arange(GRID_W), rows).astype(jnp.float32)
    n_freq = HEAD_DIM // 4
    freqs = ROPE_THETA ** (-jnp.arange(n_freq, dtype=jnp.float32) / n_freq)
    ang = jnp.stack([row[:, None] * freqs, col[:, None] * freqs], axis=1)
    return jnp.cos(ang)[:, None], jnp.sin(ang)[:, None]


def apply_rope(x, cos, sin):
    B, S, H, _ = x.shape
    xr = x.astype(jnp.float32).reshape(B, S, H, 2, 2, HEAD_DIM // 4)
    x1, x2 = xr[..., 0, :], xr[..., 1, :]
    out = jnp.stack([x1 * cos - x2 * sin, x2 * cos + x1 * sin], axis=-2)
    return out.reshape(B, S, H, HEAD_DIM).astype(x.dtype)


def modulation(cvec, w_ada_l, b_ada_l):
    mod = jax.nn.silu(cvec) @ w_ada_l + b_ada_l
    return jnp.split(mod, 3, axis=-1)


def qkv_heads(q, k, v, qw, kw):
    B, T = q.shape[:2]
    q = rmsnorm(q.reshape(B, T, N_Q_HEADS, HEAD_DIM), qw)
    k = rmsnorm(k.reshape(B, T, N_KV_HEADS, HEAD_DIM), kw)
    v = v.reshape(B, T, N_KV_HEADS, HEAD_DIM)
    return q, k, v


def gqa_attend(q_blk, k, v):
    s = jnp.einsum('bqkgd,bskd->bkgqs', q_blk, k).astype(jnp.float32) * (HEAD_DIM ** -0.5)
    p = jax.nn.softmax(s, axis=-1).astype(v.dtype)
    return jnp.einsum('bkgqs,bskd->bqkgd', p, v)


def latent_attention(q, k_all, v_all):
    B, S = q.shape[:2]
    n_blk = S // Q_BLOCK
    qb = q.reshape(B, n_blk, Q_BLOCK, N_KV_HEADS, Q_PER_KV, HEAD_DIM).transpose(1, 0, 2, 3, 4, 5)
    out = lax.map(lambda q_blk: gqa_attend(q_blk, k_all, v_all), qb)
    return out.transpose(1, 0, 2, 3, 4, 5).reshape(B, S, D_ATT)


def short_conv(x, w, b):
    y = lax.conv_general_dilated(x, w[:, None, :].astype(x.dtype), window_strides=(1,),
                                 padding=[CONV_PAD], dimension_numbers=('NWC', 'WIO', 'NWC'),
                                 feature_group_count=x.shape[-1])
    return y + b.astype(x.dtype)


def rglru_coeffs(x, wa, ba, wx, bx, lam):
    xb = x.reshape(*x.shape[:-1], LRU_BLOCKS, LRU_BLOCK_DIM)
    r = jax.nn.sigmoid(jnp.einsum('btni,nij->btnj', xb, wa.astype(jnp.float32)).reshape(x.shape) + ba.astype(jnp.float32))
    i = jax.nn.sigmoid(jnp.einsum('btni,nij->btnj', xb, wx.astype(jnp.float32)).reshape(x.shape) + bx.astype(jnp.float32))
    log_a = -LRU_C * r * jax.nn.softplus(-lam.astype(jnp.float32))
    a = jnp.exp(log_a)
    mult = jnp.sqrt(-jnp.expm1(2.0 * log_a))
    return a, mult * (i * x)


def _lin_combine(e1, e2):
    a1, b1 = e1
    a2, b2 = e2
    return a1 * a2, a2 * b1 + b2


def linear_scan(a, b, reverse):
    return lax.associative_scan(_lin_combine, (a, b), axis=1, reverse=reverse)


def setup_inputs(seed: int = 0) -> dict:
    key = jax.random.key(seed)
    ks = jax.random.split(key, 20)
    f32 = jnp.float32
    nrm = lambda k, shape, s: jax.random.normal(k, shape, f32) * s
    a0 = jax.random.uniform(ks[16], (DEPTH, 2, D_LRU), f32, 0.9, 0.999)
    a_base = a0 ** (1.0 / LRU_C)
    lam = jnp.log(a_base) - jnp.log1p(-a_base)
    return {
        "x": nrm(ks[0], (BATCH, SEQ, D_MODEL), 1.0),
        "c": nrm(ks[1], (BATCH, D_MODEL), 1.0),
        "ctx": nrm(ks[2], (BATCH, CTX_LEN, D_MODEL), 1.0),
        "c_ctx": nrm(ks[3], (D_MODEL,), 1.0),
        "w_ada": nrm(ks[4], (DEPTH, D_MODEL, 3 * D_MODEL), D_MODEL ** -0.5),
        "b_ada": nrm(ks[5], (DEPTH, 3 * D_MODEL), 0.01),
        "norm_w": 1.0 + nrm(ks[6], (DEPTH, D_MODEL), 0.01),
        "w_in": nrm(ks[7], (DEPTH, D_MODEL, D_IN), D_MODEL ** -0.5),
        "q_norm_w": 1.0 + nrm(ks[8], (DEPTH, HEAD_DIM), 0.01),
        "k_norm_w": 1.0 + nrm(ks[9], (DEPTH, HEAD_DIM), 0.01),
        "conv_w": nrm(ks[10], (DEPTH, CONV_WIDTH, D_LRU), CONV_WIDTH ** -0.5),
        "conv_b": nrm(ks[11], (DEPTH, D_LRU), 0.01),
        "lru_wa": nrm(ks[12], (DEPTH, 2, LRU_BLOCKS, LRU_BLOCK_DIM, LRU_BLOCK_DIM), LRU_BLOCK_DIM ** -0.5),
        "lru_ba": nrm(ks[13], (DEPTH, 2, D_LRU), 0.01),
        "lru_wx": nrm(ks[14], (DEPTH, 2, LRU_BLOCKS, LRU_BLOCK_DIM, LRU_BLOCK_DIM), LRU_BLOCK_DIM ** -0.5),
        "lru_bx": nrm(ks[15], (DEPTH, 2, D_LRU), 0.01),
        "lru_lambda": lam,
        "out_norm_att": 1.0 + nrm(ks[17], (DEPTH, D_ATT), 0.01),
        "out_norm_lru": 1.0 + nrm(ks[18], (DEPTH, D_LRU), 0.01),
        "w_out": nrm(ks[19], (DEPTH, D_MIX, D_MODEL), D_MIX ** -0.5),
    }


def reference(x, c, ctx, c_ctx, w_ada, b_ada, norm_w, w_in, q_norm_w, k_norm_w, conv_w, conv_b,
              lru_wa, lru_ba, lru_wx, lru_bx, lru_lambda, out_norm_att, out_norm_lru, w_out):
    B, S, _ = x.shape
    C = ctx.shape[1]
    cos, sin = rope_tables(S)
    for l in range(DEPTH):
        last = l + 1 == DEPTH
        shift_x, scale_x, gate_x = modulation(c, w_ada[l], b_ada[l])
        shift_c, scale_c, gate_c = modulation(c_ctx, w_ada[l], b_ada[l])
        h_x = rmsnorm(x, norm_w[l]) * (1.0 + scale_x[:, None]) + shift_x[:, None]
        h_c = rmsnorm(ctx, norm_w[l]) * (1.0 + scale_c) + shift_c
        q_x, k_x, v_x, ga_x, xl_x, gl_x = jnp.split(h_x @ w_in[l], SPLITS, axis=-1)
        q_c, k_c, v_c, ga_c, xl_c, gl_c = jnp.split(h_c @ w_in[l], SPLITS, axis=-1)

        q_x, k_x, v_x = qkv_heads(q_x, k_x, v_x, q_norm_w[l], k_norm_w[l])
        q_c, k_c, v_c = qkv_heads(q_c, k_c, v_c, q_norm_w[l], k_norm_w[l])
        q_x = apply_rope(q_x, cos, sin)
        k_x = apply_rope(k_x, cos, sin)
        k_all = jnp.concatenate([k_x, k_c], axis=1)
        v_all = jnp.concatenate([v_x, v_c], axis=1)
        att_x = latent_attention(q_x, k_all, v_all)

        u_x = short_conv(xl_x, conv_w[l], conv_b[l]).astype(jnp.float32)
        u_c = short_conv(xl_c, conv_w[l], conv_b[l]).astype(jnp.float32)
        lru_x = jnp.zeros(u_x.shape, jnp.float32)
        lru_c = jnp.zeros(u_c.shape, jnp.float32)
        for d in range(2):
            rev = d == 1
            p = (lru_wa[l, d], lru_ba[l, d], lru_wx[l, d], lru_bx[l, d], lru_lambda[l, d])
            a_c, b_c = rglru_coeffs(u_c, *p)
            _, h_c_states = linear_scan(a_c, b_c, rev)
            h0 = h_c_states[:, 0] if rev else h_c_states[:, -1]
            a_l, b_l = rglru_coeffs(u_x, *p)
            a_cum, h_l = linear_scan(a_l, b_l, rev)
            lru_x = lru_x + h_l + a_cum * h0[:, None]
            lru_c = lru_c + h_c_states
        lru_x = lru_x.astype(x.dtype)

        mix_x = jnp.concatenate([rmsnorm(att_x, out_norm_att[l]) * jax.nn.silu(ga_x),
                                 rmsnorm(lru_x, out_norm_lru[l]) * jax.nn.silu(gl_x)], axis=-1)
        x_new = x + gate_x[:, None] * (mix_x @ w_out[l])

        if not last:
            qc = q_c.reshape(B, C, N_KV_HEADS, Q_PER_KV, HEAD_DIM)
            att_c = gqa_attend(qc, k_c, v_c).reshape(B, C, D_ATT)
            mix_c = jnp.concatenate([rmsnorm(att_c, out_norm_att[l]) * jax.nn.silu(ga_c),
                                     rmsnorm(lru_c.astype(ctx.dtype), out_norm_lru[l]) * jax.nn.silu(gl_c)], axis=-1)
            ctx = ctx + gate_c * (mix_c @ w_out[l])
        x = x_new
    return x
```

```cpp
#include <hip/hip_runtime.h>
#include <hip/hip_bf16.h>
#include <hip/hip_cooperative_groups.h>
#include <cstdio>
#include <cstdint>
namespace pg8 {
#define PG8_LAS __attribute__((address_space(3)))
typedef unsigned short bf16_t;
typedef short bf16x8 __attribute__((ext_vector_type(8)));
typedef float f32x4 __attribute__((ext_vector_type(4)));
typedef unsigned u32x4 __attribute__((ext_vector_type(4)));
constexpr int BM = 256, BK = 64, HALF = 128, HTB = HALF * BK * 2  , STAGE_BYTES = 8 * HTB, NXCD = 8, WGM = 8;

__host__ __device__ __forceinline__ int lds_byte(int r, int c) { const int st = (r >> 4) * 2 + (c >> 5), rr = r & 15, cc = c & 31, ob = rr * 64 + cc * 2; return st * 1024 + (ob ^ (((ob >> 9) & 1) << 5)); }
__host__ __device__ __forceinline__ void stage_rc(int b, int& R, int& C) { const int st = b / 1024, sb = b % 1024, swz = sb ^ (((sb >> 9) & 1) << 5); R = (st >> 1) * 16 + swz / 64; C = (st & 1) * 32 + (swz % 64) / 2; }
__host__ __device__ __forceinline__ int perm32(int rho) { const int n = rho >> 4, i = rho & 15; return 8 * (i >> 2) + 4 * n + (i & 3); }

struct Unit { int pm, pn; };
struct Gemm { const bf16_t* A; const bf16_t* Bt; int M, N, K; };

struct StaticOrder {
    int nM, nN, nwg, G, c;
    __host__ __device__ void init(int M, int N, int G_, int c_) { nM = M / BM; nN = N / BM; nwg = nM * nN; G = G_; c = c_; }
    __host__ __device__ bool next(int i, Unit& u) const {
        const long L = (long)i * G + c; if (L >= nwg) return false;
        int wgid = (int)L; { const int q = nwg / NXCD, r = nwg % NXCD, xcd = wgid % NXCD, off = wgid / NXCD; wgid = (xcd < r ? xcd * (q + 1) : r * (q + 1) + (xcd - r) * q) + off; }
        const int nig = WGM * nN, gid = wgid / nig, fm = gid * WGM, gsz = (nM - fm) < WGM ? (nM - fm) : WGM;
        u.pm = fm + ((wgid % nig) % gsz); u.pn = (wgid % nig) / gsz; return true;
    }
    __device__ __forceinline__ void a_ready(const Unit&) const {}
    __device__ __forceinline__ void done(const Unit&) const {}
};

__device__ __forceinline__ unsigned cvt_pk_bf16(float lo, float hi) { unsigned r; asm volatile("v_cvt_pk_bf16_f32 %0, %1, %2" : "=v"(r) : "v"(lo), "v"(hi)); return r; }
struct EpiBf16 {
    static constexpr bool PERM = true, AFTER_DRAIN = false;
    bf16_t* O; int ldc;
    __device__ __forceinline__ void operator()(const f32x4 (&acc)[2][2][4][2], const Unit& u, int wr, int wc, int fr, int fq) const {
        const int row0 = u.pm * BM + wr * 64 + fr; const int col0 = u.pn * BM + wc * 32 + 8 * fq;
#pragma unroll
        for (int ai = 0; ai < 2; ++ai)
#pragma unroll
            for (int m = 0; m < 4; ++m) { bf16_t* rowp = O + (size_t)(row0 + ai * HALF + m * 16) * ldc + col0;
#pragma unroll
                for (int bj = 0; bj < 2; ++bj) { const f32x4 v0 = acc[ai][bj][m][0], v1 = acc[ai][bj][m][1];
                    u32x4 w; w.x = cvt_pk_bf16(v0[0], v0[1]); w.y = cvt_pk_bf16(v0[2], v0[3]); w.z = cvt_pk_bf16(v1[0], v1[1]); w.w = cvt_pk_bf16(v1[2], v1[3]);
                    *(u32x4*)(rowp + bj * HALF) = w; } }
    }
};
struct EpiResid {
    static constexpr bool PERM = false, AFTER_DRAIN = false;
    const float* base; float* out; int ldc; const float* gate; int gate_ld; int rows_per_batch;
    __device__ __forceinline__ void operator()(const f32x4 (&acc)[2][2][4][2], const Unit& u, int wr, int wc, int fr, int fq) const {
        const int row0 = u.pm * BM + wr * 64 + fr, col0 = u.pn * BM + wc * 32 + 4 * fq;
        const float* g = gate + (size_t)((u.pm * BM) / rows_per_batch) * gate_ld + col0;
        f32x4 gv[2][2];
#pragma unroll
        for (int bj = 0; bj < 2; ++bj)
#pragma unroll
            for (int n = 0; n < 2; ++n) gv[bj][n] = *(const f32x4*)(g + bj * HALF + n * 16);
#pragma unroll
        for (int ai = 0; ai < 2; ++ai)
#pragma unroll
            for (int m = 0; m < 4; ++m) { const size_t off = (size_t)(row0 + ai * HALF + m * 16) * ldc + col0;
#pragma unroll
                for (int bj = 0; bj < 2; ++bj)
#pragma unroll
                    for (int n = 0; n < 2; ++n) { const f32x4 bs = *(const f32x4*)(base + off + bj * HALF + n * 16);
                        *(f32x4*)(out + off + bj * HALF + n * 16) = bs + gv[bj][n] * acc[ai][bj][m][n]; } }
    }
};
template <class Epi, class Sched, bool ALIGN_EPI = false, bool SP2 = false>
__device__ __forceinline__ void gemm_phase(PG8_LAS unsigned char* lds, const Gemm g, const Sched& S, const Epi& E) {
    const int tid = threadIdx.x, wid = __builtin_amdgcn_readfirstlane(tid >> 6), lane = tid & 63, wr = wid >> 2, wc = wid & 3, fr = lane & 15, fq = lane >> 4;
    const int K = g.K, nt = K / BK;
    unsigned voffA[2], voffB[2];
#pragma unroll
    for (int i = 0; i < 2; ++i) { int R, C; stage_rc(tid * 16 + i * 8192, R, C); const int Rb = Epi::PERM ? ((R & ~31) + perm32(R & 31)) : R;
        voffA[i] = (unsigned)(R * K + C) * 2u; voffB[i] = (unsigned)(Rb * K + C) * 2u; }
    const size_t kstep = (size_t)(BK * 2);
    const size_t hstep = (size_t)HALF * K * 2;
    const size_t tstep = 2 * hstep;
    const unsigned ldsw = (unsigned)wid * 1024u;
    const int aoff = lds_byte(wr * 64 + fr, fq * 8), boff = lds_byte(wc * 32 + fr, fq * 8);
#define PG8_SA(b, h) (((b) * 2 + (h)) * HTB)
#define PG8_SB(b, h) ((4 + (b) * 2 + (h)) * HTB)
#define PG8_STAGE(bufoff, gbase, voff) do { _Pragma("unroll") for (int _i = 0; _i < 2; ++_i) \
        __builtin_amdgcn_global_load_lds((const unsigned*)((const char*)(gbase) + (voff)[_i]), (PG8_LAS unsigned*)(lds + (bufoff) + ldsw + _i * 8192), 16, 0, 0); } while (0)
#define PG8_LDA(dst, b, h) do { _Pragma("unroll") for (int m = 0; m < 4; ++m) _Pragma("unroll") for (int k = 0; k < 2; ++k) dst[m][k] = *(const PG8_LAS bf16x8*)(lds + PG8_SA(b, h) + aoff + m * 2048 + k * 1024); } while (0)
#define PG8_LDB(dst, b, h) do { _Pragma("unroll") for (int n = 0; n < 2; ++n) _Pragma("unroll") for (int k = 0; k < 2; ++k) dst[n][k] = *(const PG8_LAS bf16x8*)(lds + PG8_SB(b, h) + boff + n * 2048 + k * 1024); } while (0)
#define PG8_MMA(ai, bj, At, Bt) do { __builtin_amdgcn_s_setprio(1); _Pragma("unroll") for (int m = 0; m < 4; ++m) _Pragma("unroll") for (int n = 0; n < 2; ++n) _Pragma("unroll") for (int k = 0; k < 2; ++k) \
        acc[ai][bj][m][n] = __builtin_amdgcn_mfma_f32_16x16x32_bf16(Bt[n][k], At[m][k], acc[ai][bj][m][n], 0, 0, 0); __builtin_amdgcn_s_setprio(0); } while (0)
#define PG8_WAIT_V(n) asm volatile("s_waitcnt vmcnt(" #n ")" ::: "memory")
#define PG8_WAIT_L(n) asm volatile("s_waitcnt lgkmcnt(" #n ")" ::: "memory")
#define PG8_BAR __builtin_amdgcn_s_barrier()
#define PG8_SCHED __builtin_amdgcn_sched_barrier(0)
    Unit cur, nxt; int ui = 0;
    if (!S.next(0, cur)) return;
    f32x4 acc[2][2][4][2];
#pragma unroll
    for (int a = 0; a < 2; ++a)
#pragma unroll
        for (int b = 0; b < 2; ++b)
#pragma unroll
            for (int m = 0; m < 4; ++m)
#pragma unroll
                for (int n = 0; n < 2; ++n) acc[a][b][m][n] = (f32x4){0.f, 0.f, 0.f, 0.f};
    bf16x8 At[4][2], B0[2][2], B1[2][2];
    const char* cA = (const char*)g.A + (size_t)cur.pm * tstep; const char* cB = (const char*)g.Bt + (size_t)cur.pn * tstep;
    S.a_ready(cur);
    if constexpr (SP2) {
        PG8_STAGE(PG8_SB(0, 0), cB, voffB); PG8_STAGE(PG8_SB(0, 1), cB + hstep, voffB); PG8_STAGE(PG8_SA(0, 0), cA, voffA); PG8_STAGE(PG8_SA(0, 1), cA + hstep, voffA);
        if (wr == 1) PG8_BAR;
        PG8_WAIT_V(2); PG8_BAR;
        PG8_STAGE(PG8_SB(1, 0), cB + kstep, voffB); PG8_STAGE(PG8_SA(1, 0), cA + kstep, voffA); PG8_STAGE(PG8_SB(1, 1), cB + hstep + kstep, voffB);
        PG8_WAIT_V(6); PG8_BAR;
    } else {
        PG8_STAGE(PG8_SB(0, 0), cB, voffB); PG8_STAGE(PG8_SA(0, 0), cA, voffA); PG8_STAGE(PG8_SB(0, 1), cB + hstep, voffB); PG8_STAGE(PG8_SA(0, 1), cA + hstep, voffA);
        if (wr == 1) PG8_BAR;
        PG8_WAIT_V(4); PG8_BAR;
        PG8_STAGE(PG8_SB(1, 0), cB + kstep, voffB); PG8_STAGE(PG8_SA(1, 0), cA + kstep, voffA); PG8_STAGE(PG8_SB(1, 1), cB + hstep + kstep, voffB);
        PG8_WAIT_V(6); PG8_BAR;
    }
    for (;;) {
        const bool has_next = S.next(ui + 1, nxt);
        const char* nA = has_next ? (const char*)g.A + (size_t)nxt.pm * tstep : cA; const char* nB = has_next ? (const char*)g.Bt + (size_t)nxt.pn * tstep : cB;
        for (int t = 0; t < nt; t += 2) {
            const bool last = (t == nt - 2);
            const char* a1 = cA + (size_t)(t + 1) * kstep;
            const char* a2 = last ? nA : cA + (size_t)(t + 2) * kstep; const char* b2 = last ? nB : cB + (size_t)(t + 2) * kstep;
            const char* a3 = a2 + kstep; const char* b3 = b2 + kstep;
            if (last && has_next) S.a_ready(nxt);
            if constexpr (SP2) {
            PG8_LDB(B0, 0, 0); PG8_LDB(B1, 0, 1); PG8_SCHED; PG8_LDA(At, 0, 0); PG8_STAGE(PG8_SA(1, 1), a1 + hstep, voffA);
            PG8_WAIT_V(8); PG8_WAIT_L(0); PG8_BAR; PG8_MMA(0, 0, At, B0); PG8_MMA(0, 1, At, B1); PG8_BAR; PG8_SCHED;
            PG8_LDA(At, 0, 1); PG8_STAGE(PG8_SB(0, 0), b2, voffB); PG8_STAGE(PG8_SB(0, 1), b2 + hstep, voffB); PG8_STAGE(PG8_SA(0, 0), a2, voffA);
            PG8_WAIT_V(8); PG8_WAIT_L(0); PG8_BAR; PG8_MMA(1, 0, At, B0); PG8_MMA(1, 1, At, B1); PG8_BAR; PG8_SCHED;
            PG8_LDB(B0, 1, 0); PG8_LDB(B1, 1, 1); PG8_SCHED; PG8_LDA(At, 1, 0); PG8_STAGE(PG8_SA(0, 1), a2 + hstep, voffA);
            PG8_WAIT_V(8); PG8_WAIT_L(0); PG8_BAR; PG8_MMA(0, 0, At, B0); PG8_MMA(0, 1, At, B1); PG8_BAR; PG8_SCHED;
            PG8_LDA(At, 1, 1); PG8_STAGE(PG8_SB(1, 0), b3, voffB); PG8_STAGE(PG8_SB(1, 1), b3 + hstep, voffB); PG8_STAGE(PG8_SA(1, 0), a3, voffA);
            PG8_WAIT_V(8); PG8_WAIT_L(0); PG8_BAR; PG8_MMA(1, 0, At, B0); PG8_MMA(1, 1, At, B1); PG8_BAR; PG8_SCHED;
            } else {
            PG8_LDB(B0, 0, 0); PG8_SCHED; PG8_LDA(At, 0, 0); PG8_STAGE(PG8_SA(1, 1), a1 + hstep, voffA);
            PG8_WAIT_L(8); PG8_BAR; PG8_WAIT_L(0); PG8_MMA(0, 0, At, B0); PG8_BAR; PG8_SCHED;
            PG8_LDB(B1, 0, 1); PG8_STAGE(PG8_SB(0, 0), b2, voffB);
            PG8_BAR; PG8_WAIT_L(0); PG8_MMA(0, 1, At, B1); PG8_BAR;
            PG8_LDA(At, 0, 1); PG8_STAGE(PG8_SA(0, 0), a2, voffA);
            PG8_BAR; PG8_WAIT_L(0); PG8_MMA(1, 0, At, B0); PG8_BAR; PG8_SCHED;
            PG8_STAGE(PG8_SB(0, 1), b2 + hstep, voffB);
            PG8_WAIT_V(6); PG8_BAR; PG8_MMA(1, 1, At, B1); PG8_BAR;
            PG8_LDB(B0, 1, 0); PG8_SCHED; PG8_LDA(At, 1, 0); PG8_STAGE(PG8_SA(0, 1), a2 + hstep, voffA);
            PG8_WAIT_L(8); PG8_BAR; PG8_WAIT_L(0); PG8_MMA(0, 0, At, B0); PG8_BAR; PG8_SCHED;
            PG8_LDB(B1, 1, 1); PG8_STAGE(PG8_SB(1, 0), b3, voffB);
            PG8_BAR; PG8_WAIT_L(0); PG8_MMA(0, 1, At, B1); PG8_BAR;
            PG8_LDA(At, 1, 1); PG8_STAGE(PG8_SA(1, 0), a3, voffA);
            PG8_BAR; PG8_WAIT_L(0); PG8_MMA(1, 0, At, B0); PG8_BAR; PG8_SCHED;
            PG8_STAGE(PG8_SB(1, 1), b3 + hstep, voffB);
            PG8_WAIT_V(6); PG8_BAR; PG8_MMA(1, 1, At, B1); PG8_BAR;
            }
        }
        if constexpr (ALIGN_EPI) { if (wr == 0) PG8_BAR; }
        if constexpr (!Epi::AFTER_DRAIN) { E(acc, cur, wr, wc, fr, fq); S.done(cur); }
        if (!has_next) break;
#pragma unroll
        for (int a = 0; a < 2; ++a)
#pragma unroll
            for (int b = 0; b < 2; ++b)
#pragma unroll
                for (int m = 0; m < 4; ++m)
#pragma unroll
                    for (int n = 0; n < 2; ++n) acc[a][b][m][n] = (f32x4){0.f, 0.f, 0.f, 0.f};
        cur = nxt; cA = nA; cB = nB; ++ui;
        if constexpr (ALIGN_EPI) { if (wr == 1) PG8_BAR; }
    }
    PG8_WAIT_V(0);
    if constexpr (!ALIGN_EPI) { if (wr == 0) PG8_BAR; }
    PG8_BAR;
    if constexpr (Epi::AFTER_DRAIN) { E.fused(acc, cur, wr, wc, fr, fq, lds, wid, lane); S.done(cur); }
#undef PG8_SA
#undef PG8_SB
#undef PG8_STAGE
#undef PG8_LDA
#undef PG8_LDB
#undef PG8_MMA
#undef PG8_WAIT_V
#undef PG8_WAIT_L
#undef PG8_BAR
#undef PG8_SCHED
}
}
namespace att {
using bf16 = __hip_bfloat16;
constexpr int   D = 128, NW = 8, QBLK = 32, KVBLK = 64;
constexpr float SCALE = 0.088388347648318440f;
constexpr float THR = 8.f;
constexpr int SDEPTH = 2;
constexpr int LDQ = 2048, LDK = 512, LDO = 2048;
constexpr size_t SHM_V = KVBLK * D * 2, SHM_K = KVBLK * D * 2, SHM_ATTN = 2 * SHM_V + 2 * SHM_K + NW * 64 * 4;
using bf16x8 = __attribute__((ext_vector_type(8))) short;
using s16x4  = __attribute__((ext_vector_type(4))) short;
using f32x16 = __attribute__((ext_vector_type(16))) float;
using f32x8  = __attribute__((ext_vector_type(8))) float;
using u32x4  = __attribute__((ext_vector_type(4))) unsigned;
#define KSWZ(row, colB) ((row) * 256 + ((colB) ^ (((row) & 7) << 4)))
#define SBAR() __builtin_amdgcn_sched_barrier(0)
__device__ __forceinline__ int crow(int r, int hi) { return (r & 3) + 8 * (r >> 2) + 4 * hi; }
__device__ __forceinline__ unsigned cvtpk(float lo, float hi) {
  unsigned r; asm volatile("v_cvt_pk_bf16_f32 %0, %1, %2" : "=v"(r) : "v"(lo), "v"(hi)); return r;
}
template <typename TIn> struct Stage;
template <> struct Stage<bf16>  { using T = bf16x8;
  __device__ static __forceinline__ T ld8(const bf16* p) { return *reinterpret_cast<const bf16x8*>(p); }
  __device__ static __forceinline__ bf16x8 tobf(T x) { return x; } };
template <> struct Stage<float> { using T = f32x8;
  __device__ static __forceinline__ T ld8(const float* p) { return *reinterpret_cast<const f32x8*>(p); }
  __device__ static __forceinline__ bf16x8 tobf(T x) {
    u32x4 w = {cvtpk(x[0], x[1]), cvtpk(x[2], x[3]), cvtpk(x[4], x[5]), cvtpk(x[6], x[7])}; return *reinterpret_cast<bf16x8*>(&w); } };

__device__ __forceinline__ void partialSM(f32x16& p0, f32x16& p1, float& m_reg, float& mn, float& alpha) {
  constexpr float C = SCALE * 1.4426950408889634f;
  float pmax = p0[0]; for (int r = 1; r < 16; ++r) pmax = fmaxf(pmax, p0[r]); for (int r = 0; r < 16; ++r) pmax = fmaxf(pmax, p1[r]);
  { auto rr = __builtin_amdgcn_permlane32_swap(__float_as_uint(pmax), __float_as_uint(pmax), false, false);
    pmax = fmaxf(__uint_as_float(rr[0]), __uint_as_float(rr[1])); }
  if (__builtin_expect(__all(pmax - m_reg <= THR / SCALE), 1)) { mn = m_reg; alpha = 1.f; }
  else { mn = fmaxf(m_reg, pmax); alpha = __builtin_amdgcn_exp2f((m_reg - mn) * C); m_reg = mn; }
  float mnC = -mn * C;
  for (int r = 0; r < 16; ++r) p0[r] = fmaf(p0[r], C, mnC); for (int r = 0; r < 16; ++r) p1[r] = fmaf(p1[r], C, mnC);
  for (int r = 0; r < 16; ++r) p0[r] = __builtin_amdgcn_exp2f(p0[r]);
}
__device__ __forceinline__ void finishSM(f32x16& p0, f32x16& p1, float alpha, float& l_reg, bf16x8& pa0, bf16x8& pa1, bf16x8& pa2, bf16x8& pa3) {
  for (int r = 0; r < 16; ++r) p1[r] = __builtin_amdgcn_exp2f(p1[r]);
  float ps = 0; for (int r = 0; r < 16; ++r) ps += p0[r]; for (int r = 0; r < 16; ++r) ps += p1[r];
  { auto rr = __builtin_amdgcn_permlane32_swap(__float_as_uint(ps), __float_as_uint(ps), false, false);
    ps = __uint_as_float(rr[0]) + __uint_as_float(rr[1]); }
  l_reg = l_reg * alpha + ps;
#define PK4(P, BASE, OUT) do { unsigned a0 = cvtpk(P[BASE + 0], P[BASE + 1]), a1 = cvtpk(P[BASE + 2], P[BASE + 3]);   \
    unsigned b0 = cvtpk(P[BASE + 4], P[BASE + 5]), b1 = cvtpk(P[BASE + 6], P[BASE + 7]);                              \
    auto r0 = __builtin_amdgcn_permlane32_swap(a0, b0, false, false); auto r1 = __builtin_amdgcn_permlane32_swap(a1, b1, false, false); \
    u32x4 w = {r0[0], r1[0], r0[1], r1[1]}; OUT = *reinterpret_cast<bf16x8*>(&w); } while (0)
  PK4(p0, 0, pa0); PK4(p0, 8, pa1); PK4(p1, 0, pa2); PK4(p1, 8, pa3);
#undef PK4
}
__device__ __forceinline__ void qkt(f32x16& p0, f32x16& p1, const bf16* Ks, const bf16x8* qr, int r32, int hi) {
  p0 = f32x16{}; p1 = f32x16{};
  for (int d0 = 0; d0 < 8; ++d0) { int cb = (d0 * 16 + hi * 8) * 2;
    bf16x8 b0 = *reinterpret_cast<const bf16x8*>((const char*)Ks + KSWZ(r32, cb));
    bf16x8 b1 = *reinterpret_cast<const bf16x8*>((const char*)Ks + KSWZ(32 + r32, cb));
    p0 = __builtin_amdgcn_mfma_f32_32x32x16_bf16(b0, qr[d0], p0, 0, 0, 0);
    p1 = __builtin_amdgcn_mfma_f32_32x32x16_bf16(b1, qr[d0], p1, 0, 0, 0); }
}
__device__ __forceinline__ int v_st(int k, int c) { const int kk = (k & ~0xC) | ((k & 4) << 1) | ((k & 8) >> 1); return ((kk >> 3) * 4 + (c >> 5)) * 512 + ((kk & 7) * 32 + (c & 31)) * 2; }
__device__ __forceinline__ int v_rd_base(int lane) { return ((lane & 3) << 3) | (((lane >> 2) & 3) << 6) | (((lane >> 4) & 1) << 5) | (((lane >> 5) & 1) << 8); }
constexpr int v_rd_off(int d0, int ks, int half) { return d0 * 512 + ks * 4096 + half * 2048; }
template <int OFF> __device__ __forceinline__ s16x4 tr_read(int vb) {
  s16x4 r; asm volatile("ds_read_b64_tr_b16 %0, %1 offset:%2" : "=&v"(r) : "v"(vb), "i"(OFF) : "memory"); return r;
}
template <int D0> __device__ __forceinline__ void pv_one(f32x16& od, int vb, bf16x8 pa0, bf16x8 pa1, bf16x8 pa2, bf16x8 pa3) {
  const s16x4 l0 = tr_read<v_rd_off(D0, 0, 0)>(vb), h0 = tr_read<v_rd_off(D0, 0, 1)>(vb), l1 = tr_read<v_rd_off(D0, 1, 0)>(vb), h1 = tr_read<v_rd_off(D0, 1, 1)>(vb);
  const s16x4 l2 = tr_read<v_rd_off(D0, 2, 0)>(vb), h2 = tr_read<v_rd_off(D0, 2, 1)>(vb), l3 = tr_read<v_rd_off(D0, 3, 0)>(vb), h3 = tr_read<v_rd_off(D0, 3, 1)>(vb);
  asm volatile("s_waitcnt lgkmcnt(0)" ::: "memory"); SBAR();
#define PK(L, H) (bf16x8){L[0], L[1], L[2], L[3], H[0], H[1], H[2], H[3]}
  od = __builtin_amdgcn_mfma_f32_32x32x16_bf16(pa0, PK(l0, h0), od, 0, 0, 0);
  od = __builtin_amdgcn_mfma_f32_32x32x16_bf16(pa1, PK(l1, h1), od, 0, 0, 0);
  od = __builtin_amdgcn_mfma_f32_32x32x16_bf16(pa2, PK(l2, h2), od, 0, 0, 0);
  od = __builtin_amdgcn_mfma_f32_32x32x16_bf16(pa3, PK(l3, h3), od, 0, 0, 0);
#undef PK
}
__device__ __forceinline__ void pv_d0(f32x16* o, int vb, bf16x8 pa0, bf16x8 pa1, bf16x8 pa2, bf16x8 pa3) {
  pv_one<0>(o[0], vb, pa0, pa1, pa2, pa3); pv_one<1>(o[1], vb, pa0, pa1, pa2, pa3); pv_one<2>(o[2], vb, pa0, pa1, pa2, pa3); pv_one<3>(o[3], vb, pa0, pa1, pa2, pa3);
}

template <typename TQ>
__device__ __forceinline__ void attn_dense_body(const TQ* __restrict__ Qb, const bf16* __restrict__ Kh, const bf16* __restrict__ Vh,
                                                float* __restrict__ Ob, int seq, char* lds) {
  using St = Stage<bf16>; using SQ = Stage<TQ>;
  const int tid = threadIdx.x, wid = tid >> 6, lane = tid & 63, r32 = lane & 31, hi = lane >> 5;
  bf16* V_lds = (bf16*)lds; bf16* K_lds = (bf16*)(lds + 2 * SHM_V);
  float* ws = (float*)(lds + 2 * SHM_V + 2 * SHM_K) + wid * 64; float* li_l = ws; float* al_l = ws + 32;
  float m_reg = -1e30f, l_reg = 0; f32x16 o[4] = {}; bf16x8 qr[8];
  const TQ* Qw = Qb + (long)(wid * QBLK + r32) * LDQ + hi * 8;
#pragma unroll
  for (int d0 = 0; d0 < 8; ++d0) qr[d0] = SQ::tobf(SQ::ld8(Qw + d0 * 16));
  const int sr = tid >> 4, sc = (tid & 15) * 8, vst0 = v_st(sr, sc), vst1 = v_st(32 + sr, sc);
  const int vb0 = (int)(uintptr_t)V_lds + v_rd_base(lane);
  struct { typename St::T vs0, vs1, ks0, ks1; } sr_[SDEPTH];
#define SLOAD(i, k0) do { sr_[i].vs0 = St::ld8(&Vh[(long)((k0) + sr) * LDK + sc]); sr_[i].vs1 = St::ld8(&Vh[(long)((k0) + 32 + sr) * LDK + sc]); \
    sr_[i].ks0 = St::ld8(&Kh[(long)((k0) + sr) * LDK + sc]); sr_[i].ks1 = St::ld8(&Kh[(long)((k0) + 32 + sr) * LDK + sc]); } while (0)
#define SWRITE(b, i) do { *(bf16x8*)((char*)V_lds + (b) * SHM_V + vst0) = St::tobf(sr_[i].vs0);          \
    *(bf16x8*)((char*)V_lds + (b) * SHM_V + vst1) = St::tobf(sr_[i].vs1); int kc = sc * 2;               \
    *(bf16x8*)((char*)K_lds + (b) * SHM_K + KSWZ(sr, kc)) = St::tobf(sr_[i].ks0);                       \
    *(bf16x8*)((char*)K_lds + (b) * SHM_K + KSWZ(32 + sr, kc)) = St::tobf(sr_[i].ks1); } while (0)
#define SWAIT() do { if constexpr (SDEPTH == 2) asm volatile("s_waitcnt vmcnt(4)" ::: "memory"); else asm volatile("s_waitcnt vmcnt(0)" ::: "memory"); } while (0)
#define RESC(a) do { if (__any((a) < 1.f)) { if (hi == 0) al_l[r32] = (a); asm volatile("s_waitcnt lgkmcnt(0)" ::: "memory"); \
    for (int d = 0; d < 4; ++d) for (int r = 0; r < 16; ++r) o[d][r] *= al_l[crow(r, hi)]; } } while (0)
  f32x16 pA0, pA1, pB0, pB1; float mnA, mnB, alA, alB; bf16x8 pa0, pa1, pa2, pa3; const int NT = seq / KVBLK;
  constexpr int SE = 0, SO = SDEPTH - 1;
  SLOAD(SE, 0); asm volatile("s_waitcnt vmcnt(0)" ::: "memory"); SWRITE(0, SE); __syncthreads();
  qkt(pA0, pA1, K_lds, qr, r32, hi); partialSM(pA0, pA1, m_reg, mnA, alA);
  SLOAD(SO, KVBLK); if constexpr (SDEPTH == 2) { if (2 < NT) SLOAD(SE, 2 * KVBLK); }
  SWAIT(); SWRITE(1, SO); __syncthreads();
  for (int j = 1; j + 1 < NT; j += 2) {
    SBAR(); qkt(pB0, pB1, (bf16*)((char*)K_lds + SHM_K), qr, r32, hi);
    finishSM(pA0, pA1, alA, l_reg, pa0, pa1, pa2, pa3); SBAR();
    SLOAD(SO, (j + SDEPTH) * KVBLK); SBAR();
    pv_d0(o, vb0, pa0, pa1, pa2, pa3); partialSM(pB0, pB1, m_reg, mnB, alB);
    __syncthreads(); SWAIT(); SWRITE(0, SE);
    RESC(alB); __syncthreads();
    SBAR(); qkt(pA0, pA1, K_lds, qr, r32, hi);
    finishSM(pB0, pB1, alB, l_reg, pa0, pa1, pa2, pa3); SBAR();
    if (SDEPTH == 1 || j + 3 < NT) SLOAD(SE, (j + 1 + SDEPTH) * KVBLK); SBAR();
    pv_d0(o, vb0 + (int)SHM_V, pa0, pa1, pa2, pa3); partialSM(pA0, pA1, m_reg, mnA, alA);
    __syncthreads(); SWAIT(); SWRITE(1, SO);
    RESC(alA); __syncthreads();
  }
  SBAR(); qkt(pB0, pB1, (bf16*)((char*)K_lds + SHM_K), qr, r32, hi);
  finishSM(pA0, pA1, alA, l_reg, pa0, pa1, pa2, pa3); SBAR();
  pv_d0(o, vb0, pa0, pa1, pa2, pa3); partialSM(pB0, pB1, m_reg, mnB, alB);
  __syncthreads(); RESC(alB);
  finishSM(pB0, pB1, alB, l_reg, pa0, pa1, pa2, pa3); SBAR();
  pv_d0(o, vb0 + (int)SHM_V, pa0, pa1, pa2, pa3);
  if (hi == 0) li_l[r32] = l_reg; asm volatile("s_waitcnt lgkmcnt(0)" ::: "memory");
  float rli[16];
#pragma unroll
  for (int r = 0; r < 16; ++r) rli[r] = __builtin_amdgcn_rcpf(li_l[crow(r, hi)]);
  float* Ow = Ob + (long)(wid * QBLK) * LDO;
#pragma unroll
  for (int r = 0; r < 16; ++r) { int orow = crow(r, hi);
    for (int d0 = 0; d0 < 4; ++d0) Ow[(long)orow * LDO + d0 * 32 + r32] = o[d0][r] * rli[r]; }
#undef SLOAD
#undef SWRITE
#undef SWAIT
#undef RESC
}
}

#ifndef MK_ONE_LAUNCH
#define MK_ONE_LAUNCH 0
#endif
namespace mk {
#define LAS __attribute__((address_space(3)))
typedef unsigned short bf16;
typedef float f32x4 __attribute__((ext_vector_type(4)));
typedef unsigned u32x4 __attribute__((ext_vector_type(4)));
typedef unsigned u32x2 __attribute__((ext_vector_type(2)));
constexpr int D = 4096, NB = 4, S = 2048, C = 256, HD = 128;
constexpr int DATT = 2048, NQH = 16, NKVH = 4, DKV = 512, DLRU = 2048, NBLK = 16, BD = 128;
constexpr int DIN = 9216, DMIX = 4096, DMOD = 3 * D;
constexpr int MX = NB * S, MC = NB * C, MT = MX + MC;
constexpr int SKV = S + C;
constexpr int COL_Q = 0, COL_K = 2048, COL_V = 2560, COL_GA = 3072, COL_XL = 5120, COL_GL = 7168;
constexpr float EPS = 1e-6f;
constexpr int NWAVES = 8, NTHREADS = 512;
constexpr int LDS_BYTES = 155648;
constexpr size_t MiB = 1u << 20;
constexpr size_t WS_CTL = 0, WS_MOD = 1 * MiB, WS_ROPE = 1 * MiB + 512 * 1024;
constexpr size_t WS_WIN = 2 * MiB, WS_WOUT = 74 * MiB, WS_H = 106 * MiB, WS_P = 178 * MiB, WS_Q = 340 * MiB, WS_K = 372 * MiB, WS_V = 381 * MiB;
constexpr size_t WS_ATT = 390 * MiB, WS_LF = 454 * MiB, WS_LB = 518 * MiB, WS_END = 582 * MiB, WS_MIX = WS_H;

struct Args { const float* in[20]; float* out; unsigned char* ws; int ph_lo, ph_hi; };
enum { I_X = 0, I_C, I_CTX, I_CCTX, I_WADA, I_BADA, I_NORMW, I_WIN, I_QNW, I_KNW, I_CONVW, I_CONVB, I_WA, I_BA, I_WX, I_BX, I_LAM, I_ONA, I_ONL, I_WOUT };

__device__ __forceinline__ unsigned f2bf(float f) { unsigned u = __builtin_bit_cast(unsigned, f); return (u + 0x7fffu + ((u >> 16) & 1u)) >> 16; }
__device__ __forceinline__ unsigned pk2(float lo, float hi) { return f2bf(lo) | (f2bf(hi) << 16); }
__device__ __forceinline__ float bf2f(unsigned short v) { return __builtin_bit_cast(float, (unsigned)v << 16); }
__device__ __forceinline__ float bflo(unsigned w) { return __builtin_bit_cast(float, w << 16); }
__device__ __forceinline__ float bfhi(unsigned w) { return __builtin_bit_cast(float, w & 0xffff0000u); }
__device__ __forceinline__ float wave_sum(float v) {
#pragma unroll
    for (int o = 1; o < 64; o <<= 1) v += __shfl_xor(v, o);
    return v;
}
__device__ __forceinline__ float sigmoidf_(float x) { return 1.0f / (1.0f + __expf(-x)); }
__device__ __forceinline__ float siluf_(float x) { return x / (1.0f + __expf(-x)); }

__device__ __forceinline__ void mod_item(const Args& a, LAS float* sc, LAS float* red, int item) {
    const int tid = threadIdx.x, cg = tid & 15, rg = tid >> 4;
    const float* W = a.in[I_WADA] + item * 64 + cg * 4;
    float acc[5][4];
#pragma unroll
    for (int r = 0; r < 5; ++r)
#pragma unroll
        for (int j = 0; j < 4; ++j) acc[r][j] = 0.f;
#pragma unroll 8
    for (int k = rg; k < D; k += 32) {
        const f32x4 w = *(const f32x4*)(W + (size_t)k * DMOD);
#pragma unroll
        for (int r = 0; r < 5; ++r) { const float s = sc[r * D + k];
            acc[r][0] += s * w[0]; acc[r][1] += s * w[1]; acc[r][2] += s * w[2]; acc[r][3] += s * w[3]; }
    }
#pragma unroll
    for (int r = 0; r < 5; ++r)
#pragma unroll
        for (int j = 0; j < 4; ++j) red[tid * 20 + r * 4 + j] = acc[r][j];
    __syncthreads();
    if (tid < 320) {
        const int r = tid >> 6, c = tid & 63, cgc = c >> 2, j = c & 3;
        float s = 0.f;
        for (int g = 0; g < 32; ++g) s += red[(g * 16 + cgc) * 20 + r * 4 + j];
        float* mod = (float*)(a.ws + WS_MOD);
        mod[r * DMOD + item * 64 + c] = s + a.in[I_BADA][item * 64 + c];
    }
    __syncthreads();
}
__device__ __forceinline__ void transpose_item(const float* W, int K, int N, bf16* WT, LAS float* scr, int item, int lane) {
    const int nblk = N / 32, kb = item / nblk, nb = item % nblk, k0 = 64 * kb, n0 = 32 * nb;
#pragma unroll 8
    for (int i = 0; i < 32; ++i) { const int kk = 2 * i + (lane >> 5); scr[kk * 33 + (lane & 31)] = W[(size_t)(k0 + kk) * N + n0 + (lane & 31)]; }
    asm volatile("s_waitcnt lgkmcnt(0)" ::: "memory");
    const int c = lane & 7;
#pragma unroll
    for (int j = 0; j < 4; ++j) { const int n = (lane >> 3) + 8 * j; const LAS float* s = scr + (8 * c) * 33 + n;
        u32x4 o; o.x = pk2(s[0 * 33], s[1 * 33]); o.y = pk2(s[2 * 33], s[3 * 33]); o.z = pk2(s[4 * 33], s[5 * 33]); o.w = pk2(s[6 * 33], s[7 * 33]);
        *(u32x4*)(WT + (size_t)(n0 + n) * K + k0 + 8 * c) = o; }
    asm volatile("s_waitcnt lgkmcnt(0)" ::: "memory");
}
__device__ __forceinline__ void sincos_d(float angf, float& sn, float& cs) {
    const double x = (double)angf, hp = 1.5707963267948966192;
    const double kq = __builtin_rint(x / hp); const double r = x - kq * hp, r2 = r * r;
    double s = r * (1.0 + r2 * (-1.0 / 6 + r2 * (1.0 / 120 + r2 * (-1.0 / 5040 + r2 * (1.0 / 362880 + r2 * (-1.0 / 39916800 + r2 * (1.0 / 6227020800.0)))))));
    double c = 1.0 + r2 * (-0.5 + r2 * (1.0 / 24 + r2 * (-1.0 / 720 + r2 * (1.0 / 40320 + r2 * (-1.0 / 3628800 + r2 * (1.0 / 479001600.0 + r2 * (-1.0 / 87178291200.0)))))));
    const int q = ((int)kq) & 3;
    double so, co;
    if (q == 0) { so = s; co = c; } else if (q == 1) { so = c; co = -s; } else if (q == 2) { so = -s; co = -c; } else { so = -c; co = s; }
    sn = (float)so; cs = (float)co;
}
__device__ __forceinline__ void phase_prep(const Args& a, LAS unsigned char* lds, int bid, int nb) {
    const int tid = threadIdx.x, lane = tid & 63, wave = tid >> 6;
    if (bid == nb - 1) {
        float* ct = (float*)(a.ws + WS_ROPE); float* st = ct + 64 * 32;
        for (int i = tid; i < 64 * 32; i += NTHREADS) { const int pos = i >> 5, f = i & 31;
            const float freq = exp2f(-(float)f * (13.287712379549449f / 32.0f)); const float ang = (float)pos * freq;
            float sn, cs; sincos_d(ang, sn, cs); ct[i] = cs; st[i] = sn; }
    }
    if (bid < DMOD / 64) {
        LAS float* sc = (LAS float*)lds; LAS float* red = (LAS float*)(lds + 5 * D * 4);
        for (int i = tid; i < 5 * D; i += NTHREADS) { const int r = i / D, k = i % D; const float v = r < 4 ? a.in[I_C][r * D + k] : a.in[I_CCTX][k]; sc[i] = siluf_(v); }
        __syncthreads();
        for (int it = bid; it < DMOD / 64; it += nb) mod_item(a, sc, red, it);
    }
    __syncthreads();
    LAS float* scr = (LAS float*)(lds + wave * 16384);
    const int gw = bid * NWAVES + wave, ngw = nb * NWAVES;
    constexpr int I_IN = (D / 64) * (DIN / 32), I_OUT = (DMIX / 64) * (D / 32);
    for (int it = gw; it < I_IN + I_OUT; it += ngw) {
        if (it < I_IN) transpose_item(a.in[I_WIN], D, DIN, (bf16*)(a.ws + WS_WIN), scr, it, lane);
        else transpose_item(a.in[I_WOUT], DMIX, D, (bf16*)(a.ws + WS_WOUT), scr, it - I_IN, lane);
    }
}
__device__ __forceinline__ void phase_norm(const Args& a, int bid, int nb) {
    const int tid = threadIdx.x, lane = tid & 63, wave = tid >> 6;
    const float* mod = (const float*)(a.ws + WS_MOD); bf16* H = (bf16*)(a.ws + WS_H); const float* nw = a.in[I_NORMW];
    for (int row = bid * NWAVES + wave; row < MT; row += nb * NWAVES) {
        const float* src = row < MX ? a.in[I_X] + (size_t)row * D : a.in[I_CTX] + (size_t)(row - MX) * D;
        const int bsel = row < MX ? row / S : 4;
        const float* shift = mod + bsel * DMOD; const float* scale = shift + D;
        f32x4 v[16]; float s = 0.f;
#pragma unroll
        for (int j = 0; j < 16; ++j) { v[j] = *(const f32x4*)(src + 4 * (lane + 64 * j)); s += (v[j][0] * v[j][0] + v[j][1] * v[j][1]) + (v[j][2] * v[j][2] + v[j][3] * v[j][3]); }
        s = wave_sum(s);
        const float rstd = 1.0f / sqrtf(s * (1.0f / D) + EPS);
#pragma unroll
        for (int j = 0; j < 16; ++j) { const int c = 4 * (lane + 64 * j);
            const f32x4 w = *(const f32x4*)(nw + c), sc = *(const f32x4*)(scale + c), sh = *(const f32x4*)(shift + c);
            f32x4 h;
#pragma unroll
            for (int e = 0; e < 4; ++e) h[e] = (v[j][e] * rstd * w[e]) * (1.0f + sc[e]) + sh[e];
            u32x2 o; o.x = pk2(h[0], h[1]); o.y = pk2(h[2], h[3]);
            *(u32x2*)(H + (size_t)row * D + c) = o; }
    }
}
__device__ __forceinline__ void phase_qkprep(const Args& a, int bid, int nb) {
    const int tid = threadIdx.x, lane = tid & 63, wave = tid >> 6;
    const bf16* P = (const bf16*)(a.ws + WS_P); bf16* Qb = (bf16*)(a.ws + WS_Q); bf16* Kb = (bf16*)(a.ws + WS_K); bf16* Vb = (bf16*)(a.ws + WS_V);
    const float* ct = (const float*)(a.ws + WS_ROPE); const float* st = ct + 64 * 32;
    const int hsel = lane >> 5, f = lane & 31;
    for (int idx = bid * NWAVES + wave; idx < MT * 20; idx += nb * NWAVES) {
        const int row = idx / 20, hh = idx % 20; const bool isx = row < MX;
        if (hh < NQH && !isx) continue;
        const bf16* src = P + (size_t)row * DIN + (hh < NQH ? COL_Q + hh * HD : COL_K + (hh - NQH) * HD);
        float x1 = bf2f(src[hsel * 64 + f]), x2 = bf2f(src[hsel * 64 + 32 + f]);
        const float ss = wave_sum(x1 * x1 + x2 * x2);
        const float rstd = 1.0f / sqrtf(ss * (1.0f / HD) + EPS);
        const float* w = hh < NQH ? a.in[I_QNW] : a.in[I_KNW];
        x1 = x1 * rstd * w[hsel * 64 + f]; x2 = x2 * rstd * w[hsel * 64 + 32 + f];
        int bb, tok;
        if (isx) { bb = row / S; const int t = row % S; tok = t; const int pos = hsel == 0 ? t / 64 : t % 64;
            const float cs = ct[pos * 32 + f], sn = st[pos * 32 + f];
            const float o1 = x1 * cs - x2 * sn, o2 = x2 * cs + x1 * sn; x1 = o1; x2 = o2; }
        else { bb = (row - MX) / C; tok = S + (row - MX) % C; }
        bf16* dst = hh < NQH ? Qb + (size_t)row * DATT + hh * HD : Kb + ((size_t)bb * SKV + tok) * DKV + (hh - NQH) * HD;
        dst[hsel * 64 + f] = (bf16)f2bf(x1); dst[hsel * 64 + 32 + f] = (bf16)f2bf(x2);
    }
    for (int idx = bid * NTHREADS + tid; idx < MT * 64; idx += nb * NTHREADS) {
        const int row = idx >> 6, c8 = idx & 63; const bool isx = row < MX;
        const int bb = isx ? row / S : (row - MX) / C, tok = isx ? row % S : S + (row - MX) % C;
        *(u32x4*)(Vb + ((size_t)bb * SKV + tok) * DKV + c8 * 8) = *(const u32x4*)(P + (size_t)row * DIN + COL_V + c8 * 8);
    }
}
__device__ __forceinline__ void phase_attn(const Args& a, char* lds, int bid, int nb) {
    const att::bf16* Qb = (const att::bf16*)(a.ws + WS_Q); const att::bf16* Kb = (const att::bf16*)(a.ws + WS_K); const att::bf16* Vb = (const att::bf16*)(a.ws + WS_V);
    float* O = (float*)(a.ws + WS_ATT);
    for (int item = bid; item < NB * NQH * (S / 256); item += nb) {
        const int b = item / 128, rem = item % 128, kvh = rem / 32, g = (rem % 32) / 8, qb = rem % 8, h = kvh * 4 + g;
        const size_t q0 = ((size_t)b * S + qb * 256) * DATT + h * HD, k0 = (size_t)b * SKV * DKV + kvh * HD;
        att::attn_dense_body<att::bf16>(Qb + q0, Kb + k0, Vb + k0, O + q0, SKV, lds);
        __syncthreads();
    }
}
__device__ __forceinline__ void phase_lru(const Args& a, LAS unsigned char* lds, int bid, int nb) {
    const int tid = threadIdx.x, j = tid & 127, q = tid >> 7;
    LAS float* wa_s = (LAS float*)lds; LAS float* wx_s = wa_s + 128 * 128; LAS float* u_s = wx_s + 128 * 128; LAS float* ab_s = u_s + 16 * 128;
    const bf16* P = (const bf16*)(a.ws + WS_P);
    for (int item = bid; item < NB * 2 * NBLK; item += nb) {
        const int b = item / 32, dir = (item / 16) & 1, n = item & 15, ch = n * BD + j;
        __syncthreads();
        { const float* wa = a.in[I_WA] + (size_t)(dir * NBLK + n) * BD * BD; const float* wx = a.in[I_WX] + (size_t)(dir * NBLK + n) * BD * BD;
          for (int i = tid; i < BD * BD / 4; i += NTHREADS) { *(LAS f32x4*)(wa_s + 4 * i) = *(const f32x4*)(wa + 4 * i); *(LAS f32x4*)(wx_s + 4 * i) = *(const f32x4*)(wx + 4 * i); } }
        const float ba = a.in[I_BA][dir * DLRU + ch], bx = a.in[I_BX][dir * DLRU + ch], lam = a.in[I_LAM][dir * DLRU + ch];
        const float sp = log1pf(expf(-lam));
        const float cw0 = a.in[I_CONVW][0 * DLRU + ch], cw1 = a.in[I_CONVW][1 * DLRU + ch], cw2 = a.in[I_CONVW][2 * DLRU + ch], cw3 = a.in[I_CONVW][3 * DLRU + ch], cb = a.in[I_CONVB][ch];
        float* outp = (float*)(a.ws + (dir == 0 ? WS_LF : WS_LB));
        float h = 0.f;
        __syncthreads();
        for (int p0 = 0; p0 < SKV; p0 += 16) {
            const bool isc = p0 < C;
            const int len = isc ? C : S;
            const size_t rowbase = isc ? (size_t)MX + (size_t)b * C : (size_t)b * S;
#pragma unroll
            for (int e = 0; e < 4; ++e) {
                const int pp = p0 + 4 * q + e; const int pl = isc ? pp : pp - C;
                const int tau = dir == 0 ? pl : len - 1 - pl;
                float u = cb;
                const bf16* col = P + rowbase * DIN + COL_XL + ch;
                if (tau - 2 >= 0)  u += cw0 * bf2f(col[(size_t)(tau - 2) * DIN]);
                if (tau - 1 >= 0)  u += cw1 * bf2f(col[(size_t)(tau - 1) * DIN]);
                u += cw2 * bf2f(col[(size_t)tau * DIN]);
                if (tau + 1 < len) u += cw3 * bf2f(col[(size_t)(tau + 1) * DIN]);
                u_s[(4 * q + e) * 128 + j] = u;
            }
            __syncthreads();
            float rp[4] = {0.f, 0.f, 0.f, 0.f}, ip[4] = {0.f, 0.f, 0.f, 0.f};
            for (int i = 0; i < 128; i += 4) {
                f32x4 uu[4];
#pragma unroll
                for (int e = 0; e < 4; ++e) uu[e] = *(const LAS f32x4*)(u_s + (4 * q + e) * 128 + i);
#pragma unroll
                for (int ii = 0; ii < 4; ++ii) { const float wav = wa_s[(i + ii) * 128 + j], wxv = wx_s[(i + ii) * 128 + j];
#pragma unroll
                    for (int e = 0; e < 4; ++e) { rp[e] += uu[e][ii] * wav; ip[e] += uu[e][ii] * wxv; } }
            }
#pragma unroll
            for (int e = 0; e < 4; ++e) {
                const float r = sigmoidf_(rp[e] + ba), ig = sigmoidf_(ip[e] + bx);
                const float log_a = -8.0f * r * sp; const float av = expf(log_a); const float mult = sqrtf(-expm1f(2.0f * log_a));
                const float bv = mult * (ig * u_s[(4 * q + e) * 128 + j]);
                ab_s[((4 * q + e) * 128 + j) * 2] = av; ab_s[((4 * q + e) * 128 + j) * 2 + 1] = bv;
            }
            __syncthreads();
            if (q == 0) {
#pragma unroll
                for (int e = 0; e < 16; ++e) {
                    h = ab_s[(e * 128 + j) * 2] * h + ab_s[(e * 128 + j) * 2 + 1];
                    if (!isc) { const int pl = p0 + e - C; const int tau = dir == 0 ? pl : S - 1 - pl; outp[((size_t)b * S + tau) * DLRU + ch] = h; }
                }
            }
        }
    }
}
__device__ __forceinline__ void phase_merge(const Args& a, int bid, int nb) {
    const int tid = threadIdx.x, lane = tid & 63, wave = tid >> 6;
    const bf16* P = (const bf16*)(a.ws + WS_P); const float* AT = (const float*)(a.ws + WS_ATT); const float* LF = (const float*)(a.ws + WS_LF); const float* LB = (const float*)(a.ws + WS_LB);
    bf16* MIX = (bf16*)(a.ws + WS_MIX);
    for (int row = bid * NWAVES + wave; row < MX; row += nb * NWAVES) {
        f32x4 va[8], vl[8]; float sa = 0.f, sl = 0.f;
#pragma unroll
        for (int jj = 0; jj < 8; ++jj) { const int c = 4 * (lane + 64 * jj);
            va[jj] = *(const f32x4*)(AT + (size_t)row * DATT + c);
            vl[jj] = *(const f32x4*)(LF + (size_t)row * DLRU + c) + *(const f32x4*)(LB + (size_t)row * DLRU + c);
            sa += (va[jj][0] * va[jj][0] + va[jj][1] * va[jj][1]) + (va[jj][2] * va[jj][2] + va[jj][3] * va[jj][3]);
            sl += (vl[jj][0] * vl[jj][0] + vl[jj][1] * vl[jj][1]) + (vl[jj][2] * vl[jj][2] + vl[jj][3] * vl[jj][3]); }
        sa = wave_sum(sa); sl = wave_sum(sl);
        const float ra = 1.0f / sqrtf(sa * (1.0f / DATT) + EPS), rl = 1.0f / sqrtf(sl * (1.0f / DLRU) + EPS);
#pragma unroll
        for (int jj = 0; jj < 8; ++jj) { const int c = 4 * (lane + 64 * jj);
            const f32x4 wa = *(const f32x4*)(a.in[I_ONA] + c), wl = *(const f32x4*)(a.in[I_ONL] + c);
            const u32x2 ga = *(const u32x2*)(P + (size_t)row * DIN + COL_GA + c), gl = *(const u32x2*)(P + (size_t)row * DIN + COL_GL + c);
            const float g0 = siluf_(bflo(ga.x)), g1 = siluf_(bfhi(ga.x)), g2 = siluf_(bflo(ga.y)), g3 = siluf_(bfhi(ga.y));
            const float l0 = siluf_(bflo(gl.x)), l1 = siluf_(bfhi(gl.x)), l2 = siluf_(bflo(gl.y)), l3 = siluf_(bfhi(gl.y));
            u32x2 oa, ol;
            oa.x = pk2(va[jj][0] * ra * wa[0] * g0, va[jj][1] * ra * wa[1] * g1); oa.y = pk2(va[jj][2] * ra * wa[2] * g2, va[jj][3] * ra * wa[3] * g3);
            ol.x = pk2(vl[jj][0] * rl * wl[0] * l0, vl[jj][1] * rl * wl[1] * l1); ol.y = pk2(vl[jj][2] * rl * wl[2] * l2, vl[jj][3] * rl * wl[3] * l3);
            *(u32x2*)(MIX + (size_t)row * DMIX + c) = oa; *(u32x2*)(MIX + (size_t)row * DMIX + DATT + c) = ol; }
    }
}

constexpr int NPHASE = 8;
__global__ void __launch_bounds__(NTHREADS, 2) mk_fwd(Args a) {
    extern __shared__ __attribute__((aligned(16))) unsigned char lds[];
    const int bid = blockIdx.x, nb = gridDim.x;
    const int lo = a.ph_lo, hi = a.ph_hi;
#define IN(k) (lo <= (k) && (k) < hi)
#if MK_ONE_LAUNCH
#define SEAM(k) do { if (IN(k) && IN((k) + 1)) cooperative_groups::this_grid().sync(); } while (0)
#else
#define SEAM(k) do { } while (0)
#endif
    if (IN(0)) { phase_prep(a, (LAS unsigned char*)lds, bid, nb); } SEAM(0);
    if (IN(1)) { phase_norm(a, bid, nb); } SEAM(1);
    if (IN(2)) {
        pg8::Gemm g{(const pg8::bf16_t*)(a.ws + WS_H), (const pg8::bf16_t*)(a.ws + WS_WIN), MT, DIN, D}; pg8::StaticOrder So; So.init(MT, DIN, nb, bid);
        pg8::EpiBf16 E{(pg8::bf16_t*)(a.ws + WS_P), DIN};
        pg8::gemm_phase<pg8::EpiBf16, pg8::StaticOrder, true, true>((PG8_LAS unsigned char*)lds, g, So, E);
    } SEAM(2);
    if (IN(3)) { phase_qkprep(a, bid, nb); } SEAM(3);
    if (IN(4)) { phase_attn(a, (char*)lds, bid, nb); } SEAM(4);
    if (IN(5)) { phase_lru(a, (LAS unsigned char*)lds, bid, nb); } SEAM(5);
    if (IN(6)) { phase_merge(a, bid, nb); } SEAM(6);
    if (IN(7)) {
        pg8::Gemm g{(const pg8::bf16_t*)(a.ws + WS_MIX), (const pg8::bf16_t*)(a.ws + WS_WOUT), MX, D, DMIX}; pg8::StaticOrder So; So.init(MX, D, nb, bid);
        pg8::EpiResid E{a.in[I_X], a.out, D, (const float*)(a.ws + WS_MOD) + 2 * D, DMOD, S};
        pg8::gemm_phase<pg8::EpiResid, pg8::StaticOrder, true, true>((PG8_LAS unsigned char*)lds, g, So, E);
    }
#undef IN
#undef SEAM
}
}

extern "C" void kernel_launch(void* const* d_in, const int* in_sizes, int n_in, void* d_out, int out_size, void* d_ws, size_t ws_size, hipStream_t stream) {
    using namespace mk;
    static int grid = 0;
    if (grid == 0) {
        if (n_in != 20 || in_sizes[0] != MX * D || out_size != MX * D || ws_size < WS_END) { fprintf(stderr, "kernel_launch: unexpected shapes (n_in %d, in0 %d, out %d, ws %zu)\n", n_in, n_in > 0 ? in_sizes[0] : -1, out_size, ws_size); grid = -1; return; }
        int dev = 0, cus = 0, per_cu = 0;
        (void)hipGetDevice(&dev); (void)hipDeviceGetAttribute(&cus, hipDeviceAttributeMultiprocessorCount, dev);
        if (hipFuncSetAttribute((const void*)mk_fwd, hipFuncAttributeMaxDynamicSharedMemorySize, LDS_BYTES) != hipSuccess) { fprintf(stderr, "kernel_launch: hipFuncSetAttribute failed\n"); grid = -1; return; }
        (void)hipOccupancyMaxActiveBlocksPerMultiprocessor(&per_cu, (const void*)mk_fwd, NTHREADS, LDS_BYTES);
        if (per_cu < 1) { fprintf(stderr, "kernel_launch: occupancy query says %d blocks per CU\n", per_cu); per_cu = 1; }
        (void)hipGetLastError();
        grid = cus;
    }
    if (grid < 0) return;
    Args a{};
    for (int i = 0; i < 20; ++i) a.in[i] = (const float*)d_in[i];
    a.out = (float*)d_out; a.ws = (unsigned char*)d_ws;
#if MK_ONE_LAUNCH
    a.ph_lo = 0; a.ph_hi = NPHASE;
    void* args[] = {&a};
    hipError_t e = hipLaunchCooperativeKernel((const void*)mk_fwd, dim3(grid), dim3(NTHREADS), args, LDS_BYTES, stream);
    if (e != hipSuccess) fprintf(stderr, "kernel_launch: cooperative launch failed: %s (grid %d)\n", hipGetErrorString(e), grid);
#else
    for (int p = 0; p < NPHASE; ++p) {
        a.ph_lo = p; a.ph_hi = p + 1;
        hipLaunchKernelGGL(mk_fwd, dim3(grid), dim3(NTHREADS), LDS_BYTES, stream, a);
    }
    const hipError_t le = hipPeekAtLastError();
    if (le != hipSuccess) fprintf(stderr, "kernel_launch: launch failed: %s\n", hipGetErrorName(le));
#endif
}
```

```cpp
#include <hip/hip_runtime.h>
#include <hip/hip_bf16.h>
#include <hip/hip_cooperative_groups.h>
#include <cstdio>
#include <cstdint>
namespace pg8 {
#define PG8_LAS __attribute__((address_space(3)))
typedef unsigned short bf16_t;
typedef short bf16x8 __attribute__((ext_vector_type(8)));
typedef float f32x4 __attribute__((ext_vector_type(4)));
typedef unsigned u32x4 __attribute__((ext_vector_type(4)));
constexpr int BM = 256, BK = 64, HALF = 128, HTB = HALF * BK * 2  , STAGE_BYTES = 8 * HTB, NXCD = 8, WGM = 8;

__host__ __device__ __forceinline__ int lds_byte(int r, int c) { const int st = (r >> 4) * 2 + (c >> 5), rr = r & 15, cc = c & 31, ob = rr * 64 + cc * 2; return st * 1024 + (ob ^ (((ob >> 9) & 1) << 5)); }
__host__ __device__ __forceinline__ void stage_rc(int b, int& R, int& C) { const int st = b / 1024, sb = b % 1024, swz = sb ^ (((sb >> 9) & 1) << 5); R = (st >> 1) * 16 + swz / 64; C = (st & 1) * 32 + (swz % 64) / 2; }
__host__ __device__ __forceinline__ int perm32(int rho) { const int n = rho >> 4, i = rho & 15; return 8 * (i >> 2) + 4 * n + (i & 3); }

struct Unit { int pm, pn, ui; };
struct Gemm { const bf16_t* A; const bf16_t* Bt; int M, N, K; };

struct StaticOrder {
    int nM, nN, nwg, G, c;
    __host__ __device__ void init(int M, int N, int G_, int c_) { nM = M / BM; nN = N / BM; nwg = nM * nN; G = G_; c = c_; }
    __host__ __device__ bool next(int i, Unit& u) const {
        const long L = (long)i * G + c; if (L >= nwg) return false;
        int wgid = (int)L; { const int q = nwg / NXCD, r = nwg % NXCD, xcd = wgid % NXCD, off = wgid / NXCD; wgid = (xcd < r ? xcd * (q + 1) : r * (q + 1) + (xcd - r) * q) + off; }
        const int nig = WGM * nN, gid = wgid / nig, fm = gid * WGM, gsz = (nM - fm) < WGM ? (nM - fm) : WGM;
        u.pm = fm + ((wgid % nig) % gsz); u.pn = (wgid % nig) / gsz; u.ui = i; return true;
    }
    __device__ __forceinline__ void a_ready(const Unit&) const {}
    __device__ __forceinline__ void done(const Unit&) const {}
};

__device__ __forceinline__ unsigned cvt_pk_bf16(float lo, float hi) { unsigned r; asm volatile("v_cvt_pk_bf16_f32 %0, %1, %2" : "=v"(r) : "v"(lo), "v"(hi)); return r; }
struct EpiBf16 {
    static constexpr bool PERM = true, AFTER_DRAIN = false, MIDSCALE = false;
    bf16_t* O; int ldc;
    __device__ __forceinline__ void operator()(const f32x4 (&acc)[2][2][4][2], const Unit& u, int wr, int wc, int fr, int fq) const {
        const int row0 = u.pm * BM + wr * 64 + fr; const int col0 = u.pn * BM + wc * 32 + 8 * fq;
#pragma unroll
        for (int ai = 0; ai < 2; ++ai)
#pragma unroll
            for (int m = 0; m < 4; ++m) { bf16_t* rowp = O + (size_t)(row0 + ai * HALF + m * 16) * ldc + col0;
#pragma unroll
                for (int bj = 0; bj < 2; ++bj) { const f32x4 v0 = acc[ai][bj][m][0], v1 = acc[ai][bj][m][1];
                    u32x4 w; w.x = cvt_pk_bf16(v0[0], v0[1]); w.y = cvt_pk_bf16(v0[2], v0[3]); w.z = cvt_pk_bf16(v1[0], v1[1]); w.w = cvt_pk_bf16(v1[2], v1[3]);
                    *(u32x4*)(rowp + bj * HALF) = w; } }
    }
};
struct EpiResid {
    static constexpr bool PERM = false, AFTER_DRAIN = false, MIDSCALE = true;
    const float* base; float* out; int ldc; const float* gate; int gate_ld; int rows_per_batch; const PG8_LAS float* ftab;
    __device__ __forceinline__ void midscale(f32x4 (&acc)[2][2][4][2], const Unit& u, int wr, int fr) const {
        const PG8_LAS float* ft = ftab + (u.ui & 3) * 512;
#pragma unroll
        for (int ai = 0; ai < 2; ++ai)
#pragma unroll
            for (int m = 0; m < 4; ++m) { const int rt = ai * HALF + wr * 64 + m * 16 + fr; const float ra = ft[rt * 2], rl = ft[rt * 2 + 1], q = ra / rl;
#pragma unroll
                for (int bj = 0; bj < 2; ++bj)
#pragma unroll
                    for (int n = 0; n < 2; ++n) acc[ai][bj][m][n] = acc[ai][bj][m][n] * q; }
    }
    __device__ __forceinline__ void operator()(const f32x4 (&acc)[2][2][4][2], const Unit& u, int wr, int wc, int fr, int fq) const {
        const int row0 = u.pm * BM + wr * 64 + fr, col0 = u.pn * BM + wc * 32 + 4 * fq;
        const float* g = gate + (size_t)((u.pm * BM) / rows_per_batch) * gate_ld + col0;
        const PG8_LAS float* ft = ftab + (u.ui & 3) * 512;
        f32x4 gv[2][2];
#pragma unroll
        for (int bj = 0; bj < 2; ++bj)
#pragma unroll
            for (int n = 0; n < 2; ++n) gv[bj][n] = *(const f32x4*)(g + bj * HALF + n * 16);
#pragma unroll
        for (int ai = 0; ai < 2; ++ai)
#pragma unroll
            for (int m = 0; m < 4; ++m) { const size_t off = (size_t)(row0 + ai * HALF + m * 16) * ldc + col0; const float rs = ft[(ai * HALF + wr * 64 + m * 16 + fr) * 2 + 1];
#pragma unroll
                for (int bj = 0; bj < 2; ++bj)
#pragma unroll
                    for (int n = 0; n < 2; ++n) { const f32x4 bs = *(const f32x4*)(base + off + bj * HALF + n * 16);
                        *(f32x4*)(out + off + bj * HALF + n * 16) = bs + gv[bj][n] * (acc[ai][bj][m][n] * rs); } }
    }
};
template <class Epi, class Sched, bool ALIGN_EPI = false, bool SP2 = false>
__device__ __forceinline__ void gemm_phase(PG8_LAS unsigned char* lds, const Gemm g, const Sched& S, const Epi& E) {
    const int tid = threadIdx.x, wid = __builtin_amdgcn_readfirstlane(tid >> 6), lane = tid & 63, wr = wid >> 2, wc = wid & 3, fr = lane & 15, fq = lane >> 4;
    const int K = g.K, nt = K / BK;
    unsigned voffA[2], voffB[2];
#pragma unroll
    for (int i = 0; i < 2; ++i) { int R, C; stage_rc(tid * 16 + i * 8192, R, C); const int Rb = Epi::PERM ? ((R & ~31) + perm32(R & 31)) : R;
        voffA[i] = (unsigned)(R * K + C) * 2u; voffB[i] = (unsigned)(Rb * K + C) * 2u; }
    const size_t kstep = (size_t)(BK * 2);
    const size_t hstep = (size_t)HALF * K * 2;
    const size_t tstep = 2 * hstep;
    const unsigned ldsw = (unsigned)wid * 1024u;
    const int aoff = lds_byte(wr * 64 + fr, fq * 8), boff = lds_byte(wc * 32 + fr, fq * 8);
#define PG8_SA(b, h) (((b) * 2 + (h)) * HTB)
#define PG8_SB(b, h) ((4 + (b) * 2 + (h)) * HTB)
#define PG8_STAGE(bufoff, gbase, voff) do { _Pragma("unroll") for (int _i = 0; _i < 2; ++_i) \
        __builtin_amdgcn_global_load_lds((const unsigned*)((const char*)(gbase) + (voff)[_i]), (PG8_LAS unsigned*)(lds + (bufoff) + ldsw + _i * 8192), 16, 0, 0); } while (0)
#define PG8_LDA(dst, b, h) do { _Pragma("unroll") for (int m = 0; m < 4; ++m) _Pragma("unroll") for (int k = 0; k < 2; ++k) dst[m][k] = *(const PG8_LAS bf16x8*)(lds + PG8_SA(b, h) + aoff + m * 2048 + k * 1024); } while (0)
#define PG8_LDB(dst, b, h) do { _Pragma("unroll") for (int n = 0; n < 2; ++n) _Pragma("unroll") for (int k = 0; k < 2; ++k) dst[n][k] = *(const PG8_LAS bf16x8*)(lds + PG8_SB(b, h) + boff + n * 2048 + k * 1024); } while (0)
#define PG8_MMA(ai, bj, At, Bt) do { __builtin_amdgcn_s_setprio(1); _Pragma("unroll") for (int m = 0; m < 4; ++m) _Pragma("unroll") for (int n = 0; n < 2; ++n) _Pragma("unroll") for (int k = 0; k < 2; ++k) \
        acc[ai][bj][m][n] = __builtin_amdgcn_mfma_f32_16x16x32_bf16(Bt[n][k], At[m][k], acc[ai][bj][m][n], 0, 0, 0); __builtin_amdgcn_s_setprio(0); } while (0)
#define PG8_WAIT_V(n) asm volatile("s_waitcnt vmcnt(" #n ")" ::: "memory")
#define PG8_WAIT_L(n) asm volatile("s_waitcnt lgkmcnt(" #n ")" ::: "memory")
#define PG8_BAR __builtin_amdgcn_s_barrier()
#define PG8_SCHED __builtin_amdgcn_sched_barrier(0)
    Unit cur, nxt; int ui = 0;
    if (!S.next(0, cur)) return;
    f32x4 acc[2][2][4][2];
#pragma unroll
    for (int a = 0; a < 2; ++a)
#pragma unroll
        for (int b = 0; b < 2; ++b)
#pragma unroll
            for (int m = 0; m < 4; ++m)
#pragma unroll
                for (int n = 0; n < 2; ++n) acc[a][b][m][n] = (f32x4){0.f, 0.f, 0.f, 0.f};
    bf16x8 At[4][2], B0[2][2], B1[2][2];
    const char* cA = (const char*)g.A + (size_t)cur.pm * tstep; const char* cB = (const char*)g.Bt + (size_t)cur.pn * tstep;
    S.a_ready(cur);
    if constexpr (SP2) {
        PG8_STAGE(PG8_SB(0, 0), cB, voffB); PG8_STAGE(PG8_SB(0, 1), cB + hstep, voffB); PG8_STAGE(PG8_SA(0, 0), cA, voffA); PG8_STAGE(PG8_SA(0, 1), cA + hstep, voffA);
        if (wr == 1) PG8_BAR;
        PG8_WAIT_V(2); PG8_BAR;
        PG8_STAGE(PG8_SB(1, 0), cB + kstep, voffB); PG8_STAGE(PG8_SA(1, 0), cA + kstep, voffA); PG8_STAGE(PG8_SB(1, 1), cB + hstep + kstep, voffB);
        PG8_WAIT_V(6); PG8_BAR;
    } else {
        PG8_STAGE(PG8_SB(0, 0), cB, voffB); PG8_STAGE(PG8_SA(0, 0), cA, voffA); PG8_STAGE(PG8_SB(0, 1), cB + hstep, voffB); PG8_STAGE(PG8_SA(0, 1), cA + hstep, voffA);
        if (wr == 1) PG8_BAR;
        PG8_WAIT_V(4); PG8_BAR;
        PG8_STAGE(PG8_SB(1, 0), cB + kstep, voffB); PG8_STAGE(PG8_SA(1, 0), cA + kstep, voffA); PG8_STAGE(PG8_SB(1, 1), cB + hstep + kstep, voffB);
        PG8_WAIT_V(6); PG8_BAR;
    }
    for (;;) {
        const bool has_next = S.next(ui + 1, nxt);
        const char* nA = has_next ? (const char*)g.A + (size_t)nxt.pm * tstep : cA; const char* nB = has_next ? (const char*)g.Bt + (size_t)nxt.pn * tstep : cB;
        for (int t = 0; t < nt; t += 2) {
            const bool last = (t == nt - 2);
            if constexpr (Epi::MIDSCALE) { if (t == (nt >> 1)) E.midscale(acc, cur, wr, fr); }
            const char* a1 = cA + (size_t)(t + 1) * kstep;
            const char* a2 = last ? nA : cA + (size_t)(t + 2) * kstep; const char* b2 = last ? nB : cB + (size_t)(t + 2) * kstep;
            const char* a3 = a2 + kstep; const char* b3 = b2 + kstep;
            if (last && has_next) S.a_ready(nxt);
            if constexpr (SP2) {
            PG8_LDB(B0, 0, 0); PG8_LDB(B1, 0, 1); PG8_SCHED; PG8_LDA(At, 0, 0); PG8_STAGE(PG8_SA(1, 1), a1 + hstep, voffA);
            PG8_WAIT_V(8); PG8_WAIT_L(0); PG8_BAR; PG8_MMA(0, 0, At, B0); PG8_MMA(0, 1, At, B1); PG8_BAR; PG8_SCHED;
            PG8_LDA(At, 0, 1); PG8_STAGE(PG8_SB(0, 0), b2, voffB); PG8_STAGE(PG8_SB(0, 1), b2 + hstep, voffB); PG8_STAGE(PG8_SA(0, 0), a2, voffA);
            PG8_WAIT_V(8); PG8_WAIT_L(0); PG8_BAR; PG8_MMA(1, 0, At, B0); PG8_MMA(1, 1, At, B1); PG8_BAR; PG8_SCHED;
            PG8_LDB(B0, 1, 0); PG8_LDB(B1, 1, 1); PG8_SCHED; PG8_LDA(At, 1, 0); PG8_STAGE(PG8_SA(0, 1), a2 + hstep, voffA);
            PG8_WAIT_V(8); PG8_WAIT_L(0); PG8_BAR; PG8_MMA(0, 0, At, B0); PG8_MMA(0, 1, At, B1); PG8_BAR; PG8_SCHED;
            PG8_LDA(At, 1, 1); PG8_STAGE(PG8_SB(1, 0), b3, voffB); PG8_STAGE(PG8_SB(1, 1), b3 + hstep, voffB); PG8_STAGE(PG8_SA(1, 0), a3, voffA);
            PG8_WAIT_V(8); PG8_WAIT_L(0); PG8_BAR; PG8_MMA(1, 0, At, B0); PG8_MMA(1, 1, At, B1); PG8_BAR; PG8_SCHED;
            } else {
            PG8_LDB(B0, 0, 0); PG8_SCHED; PG8_LDA(At, 0, 0); PG8_STAGE(PG8_SA(1, 1), a1 + hstep, voffA);
            PG8_WAIT_L(8); PG8_BAR; PG8_WAIT_L(0); PG8_MMA(0, 0, At, B0); PG8_BAR; PG8_SCHED;
            PG8_LDB(B1, 0, 1); PG8_STAGE(PG8_SB(0, 0), b2, voffB);
            PG8_BAR; PG8_WAIT_L(0); PG8_MMA(0, 1, At, B1); PG8_BAR;
            PG8_LDA(At, 0, 1); PG8_STAGE(PG8_SA(0, 0), a2, voffA);
            PG8_BAR; PG8_WAIT_L(0); PG8_MMA(1, 0, At, B0); PG8_BAR; PG8_SCHED;
            PG8_STAGE(PG8_SB(0, 1), b2 + hstep, voffB);
            PG8_WAIT_V(6); PG8_BAR; PG8_MMA(1, 1, At, B1); PG8_BAR;
            PG8_LDB(B0, 1, 0); PG8_SCHED; PG8_LDA(At, 1, 0); PG8_STAGE(PG8_SA(0, 1), a2 + hstep, voffA);
            PG8_WAIT_L(8); PG8_BAR; PG8_WAIT_L(0); PG8_MMA(0, 0, At, B0); PG8_BAR; PG8_SCHED;
            PG8_LDB(B1, 1, 1); PG8_STAGE(PG8_SB(1, 0), b3, voffB);
            PG8_BAR; PG8_WAIT_L(0); PG8_MMA(0, 1, At, B1); PG8_BAR;
            PG8_LDA(At, 1, 1); PG8_STAGE(PG8_SA(1, 0), a3, voffA);
            PG8_BAR; PG8_WAIT_L(0); PG8_MMA(1, 0, At, B0); PG8_BAR; PG8_SCHED;
            PG8_STAGE(PG8_SB(1, 1), b3 + hstep, voffB);
            PG8_WAIT_V(6); PG8_BAR; PG8_MMA(1, 1, At, B1); PG8_BAR;
            }
        }
        if constexpr (ALIGN_EPI) { if (wr == 0) PG8_BAR; }
        if constexpr (!Epi::AFTER_DRAIN) { E(acc, cur, wr, wc, fr, fq); S.done(cur); }
        if (!has_next) break;
#pragma unroll
        for (int a = 0; a < 2; ++a)
#pragma unroll
            for (int b = 0; b < 2; ++b)
#pragma unroll
                for (int m = 0; m < 4; ++m)
#pragma unroll
                    for (int n = 0; n < 2; ++n) acc[a][b][m][n] = (f32x4){0.f, 0.f, 0.f, 0.f};
        cur = nxt; cA = nA; cB = nB; ++ui;
        if constexpr (ALIGN_EPI) { if (wr == 1) PG8_BAR; }
    }
    PG8_WAIT_V(0);
    if constexpr (!ALIGN_EPI) { if (wr == 0) PG8_BAR; }
    PG8_BAR;
    if constexpr (Epi::AFTER_DRAIN) { E.fused(acc, cur, wr, wc, fr, fq, lds, wid, lane); S.done(cur); }
#undef PG8_SA
#undef PG8_SB
#undef PG8_STAGE
#undef PG8_LDA
#undef PG8_LDB
#undef PG8_MMA
#undef PG8_WAIT_V
#undef PG8_WAIT_L
#undef PG8_BAR
#undef PG8_SCHED
}
}
namespace att {
using bf16 = __hip_bfloat16;
constexpr int   D = 128, NW = 8, QBLK = 32, KVBLK = 64;
constexpr float SCALE = 0.088388347648318440f;
constexpr float THR = 8.f;
constexpr int SDEPTH = 2;
constexpr int LDQ = 2048, LDK = 512, LDO = 2048;
constexpr size_t SHM_V = KVBLK * D * 2, SHM_K = KVBLK * D * 2, SHM_ATTN = 5 * SHM_V + 4 * SHM_K + NW * 64 * 4;
using bf16x8 = __attribute__((ext_vector_type(8))) short;
using s16x4  = __attribute__((ext_vector_type(4))) short;
using f32x16 = __attribute__((ext_vector_type(16))) float;
using f32x8  = __attribute__((ext_vector_type(8))) float;
using u32x4  = __attribute__((ext_vector_type(4))) unsigned;
using f32x4_t = __attribute__((ext_vector_type(4))) float;
#define KSWZ(row, colB) ((row) * 256 + ((colB) ^ (((row) & 7) << 4)))
#define SBAR() __builtin_amdgcn_sched_barrier(0)
__device__ __forceinline__ int crow(int r, int hi) { return (r & 3) + 8 * (r >> 2) + 4 * hi; }
__device__ __forceinline__ unsigned cvtpk(float lo, float hi) {
  unsigned r; asm volatile("v_cvt_pk_bf16_f32 %0, %1, %2" : "=v"(r) : "v"(lo), "v"(hi)); return r;
}
template <typename TIn> struct Stage;
template <> struct Stage<bf16>  { using T = bf16x8;
  __device__ static __forceinline__ T ld8(const bf16* p) { return *reinterpret_cast<const bf16x8*>(p); }
  __device__ static __forceinline__ bf16x8 tobf(T x) { return x; } };
template <> struct Stage<float> { using T = f32x8;
  __device__ static __forceinline__ T ld8(const float* p) { return *reinterpret_cast<const f32x8*>(p); }
  __device__ static __forceinline__ bf16x8 tobf(T x) {
    u32x4 w = {cvtpk(x[0], x[1]), cvtpk(x[2], x[3]), cvtpk(x[4], x[5]), cvtpk(x[6], x[7])}; return *reinterpret_cast<bf16x8*>(&w); } };

__device__ __forceinline__ void partialSM(f32x16& p0, f32x16& p1, float& m_reg, float& mn, float& alpha) {
  constexpr float C = SCALE * 1.4426950408889634f;
  float pmax = p0[0]; for (int r = 1; r < 16; ++r) pmax = fmaxf(pmax, p0[r]); for (int r = 0; r < 16; ++r) pmax = fmaxf(pmax, p1[r]);
  { auto rr = __builtin_amdgcn_permlane32_swap(__float_as_uint(pmax), __float_as_uint(pmax), false, false);
    pmax = fmaxf(__uint_as_float(rr[0]), __uint_as_float(rr[1])); }
  if (__builtin_expect(__all(pmax - m_reg <= THR / SCALE), 1)) { mn = m_reg; alpha = 1.f; }
  else { mn = fmaxf(m_reg, pmax); alpha = __builtin_amdgcn_exp2f((m_reg - mn) * C); m_reg = mn; }
  float mnC = -mn * C;
  for (int r = 0; r < 16; ++r) p0[r] = fmaf(p0[r], C, mnC); for (int r = 0; r < 16; ++r) p1[r] = fmaf(p1[r], C, mnC);
  for (int r = 0; r < 16; ++r) p0[r] = __builtin_amdgcn_exp2f(p0[r]);
}
__device__ __forceinline__ void finishSM(f32x16& p0, f32x16& p1, float alpha, float& l_reg, bf16x8& pa0, bf16x8& pa1, bf16x8& pa2, bf16x8& pa3) {
  for (int r = 0; r < 16; ++r) p1[r] = __builtin_amdgcn_exp2f(p1[r]);
  float ps = 0; for (int r = 0; r < 16; ++r) ps += p0[r]; for (int r = 0; r < 16; ++r) ps += p1[r];
  { auto rr = __builtin_amdgcn_permlane32_swap(__float_as_uint(ps), __float_as_uint(ps), false, false);
    ps = __uint_as_float(rr[0]) + __uint_as_float(rr[1]); }
  l_reg = l_reg * alpha + ps;
#define PK4(P, BASE, OUT) do { unsigned a0 = cvtpk(P[BASE + 0], P[BASE + 1]), a1 = cvtpk(P[BASE + 2], P[BASE + 3]);   \
    unsigned b0 = cvtpk(P[BASE + 4], P[BASE + 5]), b1 = cvtpk(P[BASE + 6], P[BASE + 7]);                              \
    auto r0 = __builtin_amdgcn_permlane32_swap(a0, b0, false, false); auto r1 = __builtin_amdgcn_permlane32_swap(a1, b1, false, false); \
    u32x4 w = {r0[0], r1[0], r0[1], r1[1]}; OUT = *reinterpret_cast<bf16x8*>(&w); } while (0)
  PK4(p0, 0, pa0); PK4(p0, 8, pa1); PK4(p1, 0, pa2); PK4(p1, 8, pa3);
#undef PK4
}
__device__ __forceinline__ void qkt(f32x16& p0, f32x16& p1, const bf16* Ks, const bf16x8* qr, int r32, int hi) {
  p0 = f32x16{}; p1 = f32x16{};
  for (int d0 = 0; d0 < 8; ++d0) { int cb = (d0 * 16 + hi * 8) * 2;
    bf16x8 b0 = *reinterpret_cast<const bf16x8*>((const char*)Ks + KSWZ(r32, cb));
    bf16x8 b1 = *reinterpret_cast<const bf16x8*>((const char*)Ks + KSWZ(32 + r32, cb));
    p0 = __builtin_amdgcn_mfma_f32_32x32x16_bf16(b0, qr[d0], p0, 0, 0, 0);
    p1 = __builtin_amdgcn_mfma_f32_32x32x16_bf16(b1, qr[d0], p1, 0, 0, 0); }
}
__device__ __forceinline__ int v_st(int k, int c) { const int kk = (k & ~0xC) | ((k & 4) << 1) | ((k & 8) >> 1); return ((kk >> 3) * 4 + (c >> 5)) * 512 + ((kk & 7) * 32 + (c & 31)) * 2; }
__device__ __forceinline__ int v_rd_base(int lane) { return ((lane & 3) << 3) | (((lane >> 2) & 3) << 6) | (((lane >> 4) & 1) << 5) | (((lane >> 5) & 1) << 8); }
constexpr int v_rd_off(int d0, int ks, int half) { return d0 * 512 + ks * 4096 + half * 2048; }
template <int OFF> __device__ __forceinline__ s16x4 tr_read(int vb) {
  s16x4 r; asm volatile("ds_read_b64_tr_b16 %0, %1 offset:%2" : "=&v"(r) : "v"(vb), "i"(OFF) : "memory"); return r;
}
template <int D0> __device__ __forceinline__ void pv_one(f32x16& od, int vb, bf16x8 pa0, bf16x8 pa1, bf16x8 pa2, bf16x8 pa3) {
  const s16x4 l0 = tr_read<v_rd_off(D0, 0, 0)>(vb), h0 = tr_read<v_rd_off(D0, 0, 1)>(vb), l1 = tr_read<v_rd_off(D0, 1, 0)>(vb), h1 = tr_read<v_rd_off(D0, 1, 1)>(vb);
  const s16x4 l2 = tr_read<v_rd_off(D0, 2, 0)>(vb), h2 = tr_read<v_rd_off(D0, 2, 1)>(vb), l3 = tr_read<v_rd_off(D0, 3, 0)>(vb), h3 = tr_read<v_rd_off(D0, 3, 1)>(vb);
  asm volatile("s_waitcnt lgkmcnt(0)" ::: "memory"); SBAR();
#define PK(L, H) (bf16x8){L[0], L[1], L[2], L[3], H[0], H[1], H[2], H[3]}
  od = __builtin_amdgcn_mfma_f32_32x32x16_bf16(pa0, PK(l0, h0), od, 0, 0, 0);
  od = __builtin_amdgcn_mfma_f32_32x32x16_bf16(pa1, PK(l1, h1), od, 0, 0, 0);
  od = __builtin_amdgcn_mfma_f32_32x32x16_bf16(pa2, PK(l2, h2), od, 0, 0, 0);
  od = __builtin_amdgcn_mfma_f32_32x32x16_bf16(pa3, PK(l3, h3), od, 0, 0, 0);
#undef PK
}
__device__ __forceinline__ void pv_d0(f32x16* o, int vb, bf16x8 pa0, bf16x8 pa1, bf16x8 pa2, bf16x8 pa3) {
  pv_one<0>(o[0], vb, pa0, pa1, pa2, pa3); pv_one<1>(o[1], vb, pa0, pa1, pa2, pa3); pv_one<2>(o[2], vb, pa0, pa1, pa2, pa3); pv_one<3>(o[3], vb, pa0, pa1, pa2, pa3);
}

template <typename TQ>
__device__ __forceinline__ void attn_dense_body(const TQ* __restrict__ Qb, const bf16* __restrict__ Kh, const bf16* __restrict__ Vh,
                                                const unsigned short* __restrict__ GAb, const float* __restrict__ watt, unsigned short* __restrict__ Mb, float* __restrict__ ssq, int seq, char* lds) {
  using St = Stage<bf16>; using SQ = Stage<TQ>;
  const int tid = threadIdx.x, wid = tid >> 6, lane = tid & 63, r32 = lane & 31, hi = lane >> 5;
  bf16* V_lds = (bf16*)lds; bf16* K_lds = (bf16*)(lds + 5 * SHM_V);
  float* ws = (float*)(lds + 5 * SHM_V + 4 * SHM_K) + wid * 64; float* li_l = ws; float* al_l = ws + 32;
  float m_reg = -1e30f, l_reg = 0; f32x16 o[4] = {}; bf16x8 qr[8];
  const TQ* Qw = Qb + (long)(wid * QBLK + r32) * LDQ + hi * 8;
#pragma unroll
  for (int d0 = 0; d0 < 8; ++d0) qr[d0] = SQ::tobf(SQ::ld8(Qw + d0 * 16));
  const int sr = tid >> 4, sc = (tid & 15) * 8, vst0 = v_st(sr, sc), vst1 = v_st(32 + sr, sc);
  const int vb0 = (int)(uintptr_t)V_lds + v_rd_base(lane);
  struct { typename St::T vs0, vs1, ks0, ks1; } sr_[SDEPTH];
#define SLOAD(i, k0) do { sr_[i].vs0 = St::ld8(&Vh[(long)((k0) + sr) * LDK + sc]); sr_[i].vs1 = St::ld8(&Vh[(long)((k0) + 32 + sr) * LDK + sc]); \
    sr_[i].ks0 = St::ld8(&Kh[(long)((k0) + sr) * LDK + sc]); sr_[i].ks1 = St::ld8(&Kh[(long)((k0) + 32 + sr) * LDK + sc]); } while (0)
#define SWRITE(bv, bk, i) do { *(bf16x8*)((char*)V_lds + (bv) * (int)SHM_V + vst0) = St::tobf(sr_[i].vs0);          \
    *(bf16x8*)((char*)V_lds + (bv) * (int)SHM_V + vst1) = St::tobf(sr_[i].vs1); int kc = sc * 2;               \
    *(bf16x8*)((char*)K_lds + (bk) * (int)SHM_K + KSWZ(sr, kc)) = St::tobf(sr_[i].ks0);                       \
    *(bf16x8*)((char*)K_lds + (bk) * (int)SHM_K + KSWZ(32 + sr, kc)) = St::tobf(sr_[i].ks1); } while (0)
#define SWAIT() do { if constexpr (SDEPTH == 2) asm volatile("s_waitcnt vmcnt(4)" ::: "memory"); else asm volatile("s_waitcnt vmcnt(0)" ::: "memory"); } while (0)
#define RESC(a) do { if (__any((a) < 1.f)) { if (hi == 0) al_l[r32] = (a); asm volatile("s_waitcnt lgkmcnt(0)" ::: "memory"); \
    for (int d = 0; d < 4; ++d) for (int r = 0; r < 16; ++r) o[d][r] *= al_l[crow(r, hi)]; } } while (0)
  f32x16 pA0, pA1, pB0, pB1; float mnA, mnB, alA, alB; bf16x8 pa0, pa1, pa2, pa3; const int NT = seq / KVBLK;
  static_assert(SDEPTH == 2, "two staging slots");
  constexpr int SE = 0, SO = 1;
  SLOAD(SE, 0); asm volatile("s_waitcnt vmcnt(0)" ::: "memory"); SWRITE(0, 0, SE);
  SLOAD(SO, KVBLK); SLOAD(SE, 2 * KVBLK);
  __syncthreads();
  qkt(pA0, pA1, K_lds, qr, r32, hi); partialSM(pA0, pA1, m_reg, mnA, alA);
  SWAIT(); SWRITE(1, 1, SO); if (3 < NT) SLOAD(SO, 3 * KVBLK);
  SWAIT(); SWRITE(2, 2, SE); if (4 < NT) SLOAD(SE, 4 * KVBLK);
  __syncthreads();
  int vr = 0;
#define VNEXT(v, d) ((v) + (d) >= 5 ? (v) + (d) - 5 : (v) + (d))
  for (int j = 1; j + 1 < NT; j += 2) {
    SBAR(); qkt(pB0, pB1, (bf16*)((char*)K_lds + (j & 3) * (int)SHM_K), qr, r32, hi);
    finishSM(pA0, pA1, alA, l_reg, pa0, pa1, pa2, pa3); SBAR();
    pv_d0(o, vb0 + vr * (int)SHM_V, pa0, pa1, pa2, pa3); partialSM(pB0, pB1, m_reg, mnB, alB);
    if (j + 2 < NT) { SWAIT(); SWRITE(VNEXT(vr, 3), (j + 2) & 3, SO); }
    if (j + 4 < NT) SLOAD(SO, (j + 4) * KVBLK);
    RESC(alB); vr = VNEXT(vr, 1);
    SBAR(); qkt(pA0, pA1, (bf16*)((char*)K_lds + ((j + 1) & 3) * (int)SHM_K), qr, r32, hi);
    finishSM(pB0, pB1, alB, l_reg, pa0, pa1, pa2, pa3); SBAR();
    pv_d0(o, vb0 + vr * (int)SHM_V, pa0, pa1, pa2, pa3); partialSM(pA0, pA1, m_reg, mnA, alA);
    if (j + 3 < NT) { SWAIT(); SWRITE(VNEXT(vr, 3), (j + 3) & 3, SE); }
    if (j + 5 < NT) SLOAD(SE, (j + 5) * KVBLK);
    RESC(alA); vr = VNEXT(vr, 1); __syncthreads();
  }
  SBAR(); qkt(pB0, pB1, (bf16*)((char*)K_lds + ((NT - 1) & 3) * (int)SHM_K), qr, r32, hi);
  finishSM(pA0, pA1, alA, l_reg, pa0, pa1, pa2, pa3); SBAR();
  pv_d0(o, vb0 + vr * (int)SHM_V, pa0, pa1, pa2, pa3); partialSM(pB0, pB1, m_reg, mnB, alB);
  __syncthreads(); RESC(alB);
  finishSM(pB0, pB1, alB, l_reg, pa0, pa1, pa2, pa3); SBAR();
  pv_d0(o, vb0 + VNEXT(vr, 1) * (int)SHM_V, pa0, pa1, pa2, pa3);
#undef VNEXT
  if (hi == 0) li_l[r32] = l_reg; asm volatile("s_waitcnt lgkmcnt(0)" ::: "memory");
  float rli[16];
#pragma unroll
  for (int r = 0; r < 16; ++r) rli[r] = __builtin_amdgcn_rcpf(li_l[crow(r, hi)]);
  int lz_; asm volatile("v_mov_b32 %0, 0" : "=v"(lz_));
  const int lane_e = lane + lz_, r32e = lane_e & 31, hie = lane_e >> 5;
  __syncthreads();
  char* stg = lds + wid * 8192;
  float ss[16];
#pragma unroll
  for (int r = 0; r < 16; ++r) { float s = 0.f;
#pragma unroll
    for (int d0 = 0; d0 < 4; ++d0) { const float v = o[d0][r] * rli[r]; s += v * v;
      unsigned u = __builtin_bit_cast(unsigned, v); u = (u + 0x7fffu + ((u >> 16) & 1u)) >> 16;
      *(unsigned short*)(stg + crow(r, hie) * 256 + (d0 * 32 + r32e) * 2) = (unsigned short)u; }
    ss[r] = s; }
#pragma unroll
  for (int r = 0; r < 16; ++r) { float s = ss[r]; s += __shfl_xor(s, 1); s += __shfl_xor(s, 2); s += __shfl_xor(s, 4); s += __shfl_xor(s, 8); s += __shfl_xor(s, 16); ss[r] = s; }
  if (r32e == 0) {
#pragma unroll
    for (int r = 0; r < 16; ++r) ssq[(long)(wid * QBLK + crow(r, hie)) * 16] = ss[r]; }
  {
    asm volatile("s_waitcnt lgkmcnt(0)" ::: "memory");
    const int chunk = lane_e & 15, rsub = lane_e >> 4;
    const f32x4_t w0 = *(const f32x4_t*)(watt + chunk * 8), w1 = *(const f32x4_t*)(watt + chunk * 8 + 4);
#pragma unroll
    for (int p = 0; p < 8; ++p) { const int row = p * 4 + rsub; const long grow = wid * QBLK + row;
      const u32x4 ov = *(const u32x4*)(stg + row * 256 + chunk * 16);
      const u32x4 gv = *(const u32x4*)(GAb + grow * 2048 + chunk * 8);
      u32x4 out;
#define AT_LO(x) __builtin_bit_cast(float, (x) << 16)
#define AT_HI(x) __builtin_bit_cast(float, (x) & 0xffff0000u)
      out[0] = cvtpk(AT_LO(ov[0]) * w0[0] * AT_LO(gv[0]), AT_HI(ov[0]) * w0[1] * AT_HI(gv[0]));
      out[1] = cvtpk(AT_LO(ov[1]) * w0[2] * AT_LO(gv[1]), AT_HI(ov[1]) * w0[3] * AT_HI(gv[1]));
      out[2] = cvtpk(AT_LO(ov[2]) * w1[0] * AT_LO(gv[2]), AT_HI(ov[2]) * w1[1] * AT_HI(gv[2]));
      out[3] = cvtpk(AT_LO(ov[3]) * w1[2] * AT_LO(gv[3]), AT_HI(ov[3]) * w1[3] * AT_HI(gv[3]));
#undef AT_LO
#undef AT_HI
      *(u32x4*)(Mb + grow * 4096 + chunk * 8) = out; } }
#undef SLOAD
#undef SWRITE
#undef SWAIT
#undef RESC
}
}

#ifndef MK_ONE_LAUNCH
#define MK_ONE_LAUNCH 1
#endif
namespace mk {
#define LAS __attribute__((address_space(3)))
typedef unsigned short bf16;
typedef float f32x4 __attribute__((ext_vector_type(4)));
typedef unsigned u32x4 __attribute__((ext_vector_type(4)));
typedef unsigned u32x2 __attribute__((ext_vector_type(2)));
constexpr int D = 4096, NB = 4, S = 2048, C = 256, HD = 128;
constexpr int DATT = 2048, NQH = 16, NKVH = 4, DKV = 512, DLRU = 2048, NBLK = 16, BD = 128;
constexpr int DIN = 9216, DMIX = 4096, DMOD = 3 * D;
constexpr int MX = NB * S, MC = NB * C, MT = MX + MC;
constexpr int SKV = S + C;
constexpr int COL_Q = 0, COL_K = 2048, COL_V = 2560, COL_GA = 3072, COL_XL = 5120, COL_GL = 7168;
constexpr float EPS = 1e-6f;
constexpr int NWAVES = 8, NTHREADS = 512;
constexpr int MISC_OFF = 151552, XS_OFF = MISC_OFF + 1024, LDS_BYTES = XS_OFF + 8192;
constexpr size_t MiB = 1u << 20;
constexpr size_t WS_CTL = 0, WS_MOD = 1 * MiB, WS_ROPE = 1 * MiB + 512 * 1024;
constexpr size_t WS_WIN = 2 * MiB, WS_WOUT = 74 * MiB, WS_H = 106 * MiB, WS_P = 178 * MiB, WS_Q = 340 * MiB, WS_K = 372 * MiB, WS_V = 381 * MiB;
constexpr size_t WS_ATT = 390 * MiB, WS_LF = 454 * MiB, WS_LB = 518 * MiB, WS_END = 582 * MiB, WS_MIX = WS_H;
constexpr size_t WS_SSQA = 390 * MiB, WS_SSQL = 391 * MiB;
constexpr int CW_LRU = 8192, CW_LRUF = 12288;
constexpr size_t WS_RSA_UNUSED = 392 * MiB;
constexpr size_t WS_GA = 178 * MiB, WS_GL = 210 * MiB, WS_XL = 242 * MiB;

struct Args { const float* in[20]; float* out; unsigned char* ws; int ph_lo, ph_hi; };
enum { I_X = 0, I_C, I_CTX, I_CCTX, I_WADA, I_BADA, I_NORMW, I_WIN, I_QNW, I_KNW, I_CONVW, I_CONVB, I_WA, I_BA, I_WX, I_BX, I_LAM, I_ONA, I_ONL, I_WOUT };

__device__ __forceinline__ unsigned f2bf(float f) { unsigned u = __builtin_bit_cast(unsigned, f); return (u + 0x7fffu + ((u >> 16) & 1u)) >> 16; }
__device__ __forceinline__ unsigned pk2(float lo, float hi) { return f2bf(lo) | (f2bf(hi) << 16); }
__device__ __forceinline__ float bf2f(unsigned short v) { return __builtin_bit_cast(float, (unsigned)v << 16); }
__device__ __forceinline__ float bflo(unsigned w) { return __builtin_bit_cast(float, w << 16); }
__device__ __forceinline__ float bfhi(unsigned w) { return __builtin_bit_cast(float, w & 0xffff0000u); }
__device__ __forceinline__ float wave_sum(float v) {
#pragma unroll
    for (int o = 1; o < 64; o <<= 1) v += __shfl_xor(v, o);
    return v;
}
__device__ __forceinline__ float sigmoidf_(float x) { return 1.0f / (1.0f + __expf(-x)); }
__device__ __forceinline__ float siluf_(float x) { return x / (1.0f + __expf(-x)); }

__host__ __device__ __forceinline__ int perm_row(int col) {
    if (col >= COL_V) return col;
    const int d = col & 127, a_ = d >> 6, hf = (d >> 5) & 1, fp = d & 31, wc = a_ * 2 + (fp >> 4), fq = (fp >> 2) & 3, e = fp & 3;
    return (col & ~127) + 32 * wc + 8 * fq + 4 * hf + e;
}
__device__ __forceinline__ void mod_item(const Args& a, LAS float* sc, LAS float* red, int item) {
    const int tid = threadIdx.x, cg = tid & 15, rg = tid >> 4;
    const float* W = a.in[I_WADA] + item * 64 + cg * 4;
    float acc[5][4];
#pragma unroll
    for (int r = 0; r < 5; ++r)
#pragma unroll
        for (int j = 0; j < 4; ++j) acc[r][j] = 0.f;
#pragma unroll 8
    for (int k = rg; k < D; k += 32) {
        const f32x4 w = *(const f32x4*)(W + (size_t)k * DMOD);
#pragma unroll
        for (int r = 0; r < 5; ++r) { const float s = sc[r * D + k];
            acc[r][0] += s * w[0]; acc[r][1] += s * w[1]; acc[r][2] += s * w[2]; acc[r][3] += s * w[3]; }
    }
#pragma unroll
    for (int r = 0; r < 5; ++r)
#pragma unroll
        for (int j = 0; j < 4; ++j) red[tid * 20 + r * 4 + j] = acc[r][j];
    __syncthreads();
    if (tid < 320) {
        const int r = tid >> 6, c = tid & 63, cgc = c >> 2, j = c & 3;
        float s = 0.f;
        for (int g = 0; g < 32; ++g) s += red[(g * 16 + cgc) * 20 + r * 4 + j];
        float* mod = (float*)(a.ws + WS_MOD);
        mod[r * DMOD + item * 64 + c] = s + a.in[I_BADA][item * 64 + c];
    }
    __syncthreads();
}
template <bool PERMQK, bool PROD = false> __device__ __forceinline__ void transpose_item(const float* W, int K, int N, bf16* WT, LAS float* scr, int item, int lane) {
    const int nblk = N / 32, kb = item / nblk, nb = item % nblk, k0 = 64 * kb, n0 = 32 * nb;
    if constexpr (PROD) {
        f32x4 t[8];
#pragma unroll
        for (int i = 0; i < 8; ++i) t[i] = *(const f32x4*)(W + (size_t)(k0 + 8 * i + (lane >> 3)) * N + n0 + 4 * (lane & 7));
#pragma unroll
        for (int i = 0; i < 8; ++i) { LAS float* d = scr + (8 * i + (lane >> 3)) * 33 + 4 * (lane & 7); d[0] = t[i][0]; d[1] = t[i][1]; d[2] = t[i][2]; d[3] = t[i][3]; }
    } else {
#pragma unroll 8
        for (int i = 0; i < 32; ++i) { const int kk = 2 * i + (lane >> 5); scr[kk * 33 + (lane & 31)] = W[(size_t)(k0 + kk) * N + n0 + (lane & 31)]; }
    }
    asm volatile("s_waitcnt lgkmcnt(0)" ::: "memory");
    const int c = lane & 7;
#pragma unroll
    for (int j = 0; j < 4; ++j) { const int n = (lane >> 3) + 8 * j; const LAS float* s = scr + (8 * c) * 33 + n;
        u32x4 o; o.x = pk2(s[0 * 33], s[1 * 33]); o.y = pk2(s[2 * 33], s[3 * 33]); o.z = pk2(s[4 * 33], s[5 * 33]); o.w = pk2(s[6 * 33], s[7 * 33]);
        const int nrow = PERMQK ? perm_row(n0 + n) : n0 + n;
        bf16* dp = WT + (size_t)nrow * K + k0 + 8 * c;
        if constexpr (PROD) asm volatile("global_store_dwordx4 %0, %1, off sc1\n\ts_nop 1" :: "v"(dp), "v"(o) : "memory");
        else *(u32x4*)dp = o; }
    asm volatile("s_waitcnt lgkmcnt(0)" ::: "memory");
}
constexpr int NPROD = 16;
constexpr int NEARLY = 8;
constexpr int CW_TILE = 16384;
__host__ __device__ __forceinline__ int tile_order(int j) { return (j >> 1) + 18 * (j & 1); }
__host__ __device__ __forceinline__ bool tile_is_early(int T) { const int l = T % 18; return l < NEARLY / 2; }
template <bool PROD> __device__ __forceinline__ void transpose_tile(const Args& a, LAS float* scr, int T, int wi, int nw, int lane) {
    for (int it = wi; it < 512; it += nw) { const int kb = it >> 3, j = it & 7;
        transpose_item<true, PROD>(a.in[I_WIN], D, DIN, (bf16*)(a.ws + WS_WIN), scr, kb * (DIN / 32) + 8 * T + j, lane); }
}
__device__ __forceinline__ void sincos_d(float angf, float& sn, float& cs) {
    const double x = (double)angf, hp = 1.5707963267948966192;
    const double kq = __builtin_rint(x / hp); const double r = x - kq * hp, r2 = r * r;
    double s = r * (1.0 + r2 * (-1.0 / 6 + r2 * (1.0 / 120 + r2 * (-1.0 / 5040 + r2 * (1.0 / 362880 + r2 * (-1.0 / 39916800 + r2 * (1.0 / 6227020800.0)))))));
    double c = 1.0 + r2 * (-0.5 + r2 * (1.0 / 24 + r2 * (-1.0 / 720 + r2 * (1.0 / 40320 + r2 * (-1.0 / 3628800 + r2 * (1.0 / 479001600.0 + r2 * (-1.0 / 87178291200.0)))))));
    const int q = ((int)kq) & 3;
    double so, co;
    if (q == 0) { so = s; co = c; } else if (q == 1) { so = c; co = -s; } else if (q == 2) { so = -s; co = -c; } else { so = -c; co = s; }
    sn = (float)so; cs = (float)co;
}
__device__ __forceinline__ void phase_prep(const Args& a, LAS unsigned char* lds, int bid, int nb) {
    const int tid = threadIdx.x, lane = tid & 63, wave = tid >> 6;
    if (bid == nb - 1) {
        float* ct = (float*)(a.ws + WS_ROPE); float* st = ct + 64 * 32;
        for (int i = tid; i < 64 * 32; i += NTHREADS) { const int pos = i >> 5, f = i & 31;
            const float freq = exp2f(-(float)f * (13.287712379549449f / 32.0f)); const float ang = (float)pos * freq;
            float sn, cs; sincos_d(ang, sn, cs); ct[i] = cs; st[i] = sn; }
    }
    if (bid < DMOD / 64) {
        LAS float* sc = (LAS float*)lds; LAS float* red = (LAS float*)(lds + 5 * D * 4);
        for (int i = tid; i < 5 * D; i += NTHREADS) { const int r = i / D, k = i % D; const float v = r < 4 ? a.in[I_C][r * D + k] : a.in[I_CCTX][k]; sc[i] = siluf_(v); }
        __syncthreads();
        for (int it = bid; it < DMOD / 64; it += nb) mod_item(a, sc, red, it);
    }
    __syncthreads();
    LAS float* scr = (LAS float*)(lds + wave * 16384);
    const int gw = bid * NWAVES + wave, ngw = nb * NWAVES;
    constexpr int I_IN = (D / 64) * (DIN / 32);
    if (nb == 256) {
        constexpr int NMOD = DMOD / 64;
        if (bid >= NMOD) { for (int j = 0; j < NEARLY; ++j) transpose_tile<false>(a, scr, tile_order(j), (bid - NMOD) * NWAVES + wave, (nb - NMOD) * NWAVES, lane); }
    } else { for (int it = gw; it < I_IN; it += ngw) transpose_item<true>(a.in[I_WIN], D, DIN, (bf16*)(a.ws + WS_WIN), scr, it, lane); }
}
__device__ __forceinline__ void producer_phase(const Args& a, LAS unsigned char* lds, int pidx) {
    const int lane = threadIdx.x & 63, wave = threadIdx.x >> 6;
    LAS float* scr = (LAS float*)(lds + wave * 16384);
    unsigned* cnt = (unsigned*)(a.ws + WS_CTL) + CW_TILE;
    for (int j = NEARLY; j < 36; ++j) { const int T = tile_order(j);
        transpose_tile<true>(a, scr, T, pidx * NWAVES + wave, NPROD * NWAVES, lane);
        asm volatile("s_waitcnt vmcnt(0)" ::: "memory");
        if (lane == 0) __hip_atomic_fetch_add(cnt + T * 16, 1u, __ATOMIC_RELAXED, __HIP_MEMORY_SCOPE_AGENT); }
    constexpr int I_OUT = (DMIX / 64) * (D / 32);
    for (int it = pidx * NWAVES + wave; it < I_OUT; it += NPROD * NWAVES) transpose_item<false, true>(a.in[I_WOUT], DMIX, D, (bf16*)(a.ws + WS_WOUT), scr, it, lane);
}
__device__ __forceinline__ void wout_transpose(const Args& a, LAS unsigned char* lds, int idx, int n) {
    const int lane = threadIdx.x & 63, wave = threadIdx.x >> 6;
    LAS float* scr = (LAS float*)(lds + wave * 16384);
    constexpr int I_OUT = (DMIX / 64) * (D / 32);
    for (int it = idx * NWAVES + wave; it < I_OUT; it += n * NWAVES) transpose_item<false>(a.in[I_WOUT], DMIX, D, (bf16*)(a.ws + WS_WOUT), scr, it, lane);
}
__device__ __forceinline__ void phase_norm(const Args& a, int bid, int nb) {
    const int tid = threadIdx.x, lane = tid & 63, wave = tid >> 6;
    const float* mod = (const float*)(a.ws + WS_MOD); bf16* H = (bf16*)(a.ws + WS_H); const float* nw = a.in[I_NORMW];
    for (int row = bid * NWAVES + wave; row < MT; row += nb * NWAVES) {
        const float* src = row < MX ? a.in[I_X] + (size_t)row * D : a.in[I_CTX] + (size_t)(row - MX) * D;
        const int bsel = row < MX ? row / S : 4;
        const float* shift = mod + bsel * DMOD; const float* scale = shift + D;
        f32x4 v[16]; float s = 0.f;
#pragma unroll
        for (int j = 0; j < 16; ++j) { v[j] = *(const f32x4*)(src + 4 * (lane + 64 * j)); s += (v[j][0] * v[j][0] + v[j][1] * v[j][1]) + (v[j][2] * v[j][2] + v[j][3] * v[j][3]); }
        s = wave_sum(s);
        const float rstd = 1.0f / sqrtf(s * (1.0f / D) + EPS);
#pragma unroll
        for (int j = 0; j < 16; ++j) { const int c = 4 * (lane + 64 * j);
            const f32x4 w = *(const f32x4*)(nw + c), sc = *(const f32x4*)(scale + c), sh = *(const f32x4*)(shift + c);
            f32x4 h;
#pragma unroll
            for (int e = 0; e < 4; ++e) h[e] = (v[j][e] * rstd * w[e]) * (1.0f + sc[e]) + sh[e];
            u32x2 o; o.x = pk2(h[0], h[1]); o.y = pk2(h[2], h[3]);
            *(u32x2*)(H + (size_t)row * D + c) = o; }
    }
}
__device__ __forceinline__ void phase_qkprep(const Args& a, int bid, int nb) {
    const int tid = threadIdx.x, lane = tid & 63, wave = tid >> 6;
    const bf16* P = (const bf16*)(a.ws + WS_P); bf16* Qb = (bf16*)(a.ws + WS_Q); bf16* Kb = (bf16*)(a.ws + WS_K); bf16* Vb = (bf16*)(a.ws + WS_V);
    const float* ct = (const float*)(a.ws + WS_ROPE); const float* st = ct + 64 * 32;
    const int hsel = lane >> 5, f = lane & 31;
    for (int idx = bid * NWAVES + wave; idx < MT * 20; idx += nb * NWAVES) {
        const int row = idx / 20, hh = idx % 20; const bool isx = row < MX;
        if (hh < NQH && !isx) continue;
        const bf16* src = P + (size_t)row * DIN + (hh < NQH ? COL_Q + hh * HD : COL_K + (hh - NQH) * HD);
        float x1 = bf2f(src[hsel * 64 + f]), x2 = bf2f(src[hsel * 64 + 32 + f]);
        const float ss = wave_sum(x1 * x1 + x2 * x2);
        const float rstd = 1.0f / sqrtf(ss * (1.0f / HD) + EPS);
        const float* w = hh < NQH ? a.in[I_QNW] : a.in[I_KNW];
        x1 = x1 * rstd * w[hsel * 64 + f]; x2 = x2 * rstd * w[hsel * 64 + 32 + f];
        int bb, tok;
        if (isx) { bb = row / S; const int t = row % S; tok = t; const int pos = hsel == 0 ? t / 64 : t % 64;
            const float cs = ct[pos * 32 + f], sn = st[pos * 32 + f];
            const float o1 = x1 * cs - x2 * sn, o2 = x2 * cs + x1 * sn; x1 = o1; x2 = o2; }
        else { bb = (row - MX) / C; tok = S + (row - MX) % C; }
        bf16* dst = hh < NQH ? Qb + (size_t)row * DATT + hh * HD : Kb + ((size_t)bb * SKV + tok) * DKV + (hh - NQH) * HD;
        dst[hsel * 64 + f] = (bf16)f2bf(x1); dst[hsel * 64 + 32 + f] = (bf16)f2bf(x2);
    }
    for (int idx = bid * NTHREADS + tid; idx < MT * 64; idx += nb * NTHREADS) {
        const int row = idx >> 6, c8 = idx & 63; const bool isx = row < MX;
        const int bb = isx ? row / S : (row - MX) / C, tok = isx ? row % S : S + (row - MX) % C;
        *(u32x4*)(Vb + ((size_t)bb * SKV + tok) * DKV + c8 * 8) = *(const u32x4*)(P + (size_t)row * DIN + COL_V + c8 * 8);
    }
}
__device__ __forceinline__ void phase_attn(const Args& a, char* lds, int bid, int nb) {
    const att::bf16* Qb = (const att::bf16*)(a.ws + WS_Q); const att::bf16* Kb = (const att::bf16*)(a.ws + WS_K); const att::bf16* Vb = (const att::bf16*)(a.ws + WS_V);
    const bf16* GAp = (const bf16*)(a.ws + WS_GA); bf16* MIX = (bf16*)(a.ws + WS_MIX); float* SSQA = (float*)(a.ws + WS_SSQA);
    for (int item = bid; item < NB * NQH * (S / 256); item += nb) {
        const int b = item / 128, rem = item % 128, kvh = rem / 32, g = (rem % 32) / 8, qb = rem % 8, h = kvh * 4 + g;
        const size_t row0 = (size_t)b * S + qb * 256;
        const size_t q0 = row0 * DATT + h * HD, k0 = (size_t)b * SKV * DKV + kvh * HD;
        att::attn_dense_body<att::bf16>(Qb + q0, Kb + k0, Vb + k0, GAp + q0, a.in[I_ONA] + h * HD, MIX + row0 * DMIX + h * HD, SSQA + row0 * 16 + h, SKV, lds);
        __syncthreads();
    }
}
template <int NPF> __device__ __forceinline__ void lru_merge_slice(const Args& a, int b, int n, int hc, int tid, int t0, int npass) {
    const bf16* GLp = (const bf16*)(a.ws + WS_GL); const bf16* LF = (const bf16*)(a.ws + WS_LF); const bf16* LB = (const bf16*)(a.ws + WS_LB);
    float* SSQL = (float*)(a.ws + WS_SSQL); bf16* MIX = (bf16*)(a.ws + WS_MIX);
    const int c8 = tid & 7, rsub = tid >> 3, ch0 = n * BD + hc * 64 + c8 * 8;
    const f32x4 w0 = *(const f32x4*)(a.in[I_ONL] + ch0), w1 = *(const f32x4*)(a.in[I_ONL] + ch0 + 4);
    (void)npass;
    for (int p0 = t0 / 64; p0 < t0 / 64 + NPF; p0 += NPF) {
        u32x4 f[NPF], k[NPF], gg[NPF];
#pragma unroll
        for (int j = 0; j < NPF; ++j) { const size_t o = ((size_t)(((b * NBLK + n) * 2 + hc) * S) + (p0 + j) * 64 + rsub) * 64 + c8 * 8; f[j] = *(const u32x4*)(LF + o); k[j] = *(const u32x4*)(LB + o); gg[j] = *(const u32x4*)(GLp + o); }
#pragma unroll
        for (int j = 0; j < NPF; ++j) { const size_t row = (size_t)b * S + (p0 + j) * 64 + rsub;
            float v[8]; float s = 0.f;
#pragma unroll
            for (int e = 0; e < 4; ++e) { v[2 * e] = bflo(f[j][e]) + bflo(k[j][e]); v[2 * e + 1] = bfhi(f[j][e]) + bfhi(k[j][e]); s += v[2 * e] * v[2 * e] + v[2 * e + 1] * v[2 * e + 1]; }
            s += __shfl_xor(s, 1); s += __shfl_xor(s, 2); s += __shfl_xor(s, 4);
            u32x4 oo;
            oo[0] = pk2(v[0] * w0[0] * bflo(gg[j][0]), v[1] * w0[1] * bfhi(gg[j][0])); oo[1] = pk2(v[2] * w0[2] * bflo(gg[j][1]), v[3] * w0[3] * bfhi(gg[j][1]));
            oo[2] = pk2(v[4] * w1[0] * bflo(gg[j][2]), v[5] * w1[1] * bfhi(gg[j][2])); oo[3] = pk2(v[6] * w1[2] * bflo(gg[j][3]), v[7] * w1[3] * bfhi(gg[j][3]));
            *(u32x4*)(MIX + row * DMIX + DATT + ch0) = oo;
            if (c8 == 0) SSQL[row * 32 + n * 2 + hc] = s; } }
}
typedef short bf16x8_t __attribute__((ext_vector_type(8)));
constexpr int LRU_RAW = 0, LRU_UA = 132 * 256, LRU_UF = LRU_UA + 128 * 256, LRU_XCH = LRU_UF + 128 * 256, LRU_OUT = LRU_XCH + 1024, LRU_RAW2 = LRU_OUT + 128 * 128, LRU_LDS = LRU_RAW2 + 132 * 256;
static_assert(LRU_LDS <= MISC_OFF, "LRU scratch runs into the LDS control words");
__device__ __forceinline__ void phase_lru(const Args& a, LAS unsigned char* lds, int bid, int nb) {
    const int tid = threadIdx.x, lane = tid & 63, w = __builtin_amdgcn_readfirstlane(tid >> 6), g = lane >> 4, c16 = lane & 15, cgq = w & 3, th = w >> 2;
    const bf16* XLp = (const bf16*)(a.ws + WS_XL);
    for (int item = bid; item < NB * 2 * NBLK * 2; item += nb) {
        const int b = item >> 6, dir = (item >> 5) & 1, n = (item >> 1) & 15, hc = item & 1;
        bf16x8_t Bwa[4], Bwx[4];
        { const float* wa = a.in[I_WA] + (size_t)(dir * NBLK + n) * BD * BD + hc * 64 + 16 * cgq + c16; const float* wx = a.in[I_WX] + (size_t)(dir * NBLK + n) * BD * BD + hc * 64 + 16 * cgq + c16;
#pragma unroll
          for (int ks = 0; ks < 4; ++ks) { u32x4 pa, px;
#pragma unroll
              for (int jj = 0; jj < 4; ++jj) { const int k0 = 32 * ks + 8 * g + 2 * jj;
                  pa[jj] = pk2(wa[(size_t)k0 * BD], wa[(size_t)(k0 + 1) * BD]); px[jj] = pk2(wx[(size_t)k0 * BD], wx[(size_t)(k0 + 1) * BD]); }
              Bwa[ks] = __builtin_bit_cast(bf16x8_t, pa); Bwx[ks] = __builtin_bit_cast(bf16x8_t, px); } }
        const int chg = n * BD + hc * 64 + 16 * cgq + c16;
        const float ba = a.in[I_BA][dir * DLRU + chg], bx = a.in[I_BX][dir * DLRU + chg];
        const float sp16 = 16.0f * log1pf(expf(-a.in[I_LAM][dir * DLRU + chg]));
        constexpr float L2E = 1.4426950408889634f;
        const float nba = -ba * L2E, nbx = -bx * L2E, cav = -0.5f * L2E * sp16;
        const int chc = n * BD + 2 * lane;
        typedef float f32x2 __attribute__((ext_vector_type(2)));
        f32x2 cwv[4], cbv;
        cbv = (f32x2){a.in[I_CONVB][chc], a.in[I_CONVB][chc + 1]};
#pragma unroll
        for (int jj = 0; jj < 4; ++jj) cwv[jj] = (f32x2){a.in[I_CONVW][jj * DLRU + chc], a.in[I_CONVW][jj * DLRU + chc + 1]};
        const bool own = (lane >> 5) == hc;
        bf16* outp = (bf16*)(a.ws + (dir == 0 ? WS_LF : WS_LB));
        float h_in = 0.f;
        u32x4 R[5];
        const int lrow = tid >> 4, lc = tid & 15;
#define LRU_LOAD(k) do { const bool isc_ = (k) < 2; const int pl0_ = isc_ ? 128 * (k) : 128 * ((k) - 2), len_ = isc_ ? C : S; \
            const int tlo_ = dir == 0 ? pl0_ : len_ - 128 - pl0_; const size_t rb_ = isc_ ? (size_t)MX + (size_t)b * C : (size_t)b * S; \
            _Pragma("unroll") for (int ps = 0; ps < 5; ++ps) { const int r_ = lrow + 32 * ps, t_ = tlo_ - 2 + r_; \
                R[ps] = (u32x4){0u, 0u, 0u, 0u}; \
                if (r_ < 132 && t_ >= 0 && t_ < len_) R[ps] = *(const u32x4*)(XLp + (rb_ + t_) * DLRU + n * BD + 8 * lc); } } while (0)
#define LRU_BAR() do { asm volatile("s_waitcnt lgkmcnt(0)" ::: "memory"); __builtin_amdgcn_s_barrier(); asm volatile("" ::: "memory"); } while (0)
#define LRU_COPYOUT(kk) do { const int tl_ = dir == 0 ? 128 * ((kk) - 2) : S - 128 - 128 * ((kk) - 2); \
            _Pragma("unroll") for (int j_ = 0; j_ < 2; ++j_) { const int p_ = tid + 512 * j_, s_ = p_ >> 3, c8_ = p_ & 7, tt_ = tl_ + (dir == 0 ? s_ : 127 - s_); \
                const u32x4 v_ = *(const LAS u32x4*)(lds + LRU_OUT + s_ * 128 + c8_ * 16); bf16* p_o = outp + ((size_t)(((b * NBLK + n) * 2 + hc) * S) + tt_) * 64 + c8_ * 8; \
                asm volatile("global_store_dwordx4 %0, %1, off sc1\n\ts_nop 1" :: "v"(p_o), "v"(v_) : "memory"); } } while (0)
        const bf16* partp = (const bf16*)(a.ws + (dir == 0 ? WS_LB : WS_LF)) + (size_t)(((b * NBLK + n) * 2 + hc) * S) * 64;
        const bf16* glsp = (const bf16*)(a.ws + WS_GL) + (size_t)(((b * NBLK + n) * 2 + hc) * S) * 64;
#define LRU_MERGE_LOAD(kk) do { const int tl_ = dir == 0 ? 128 * ((kk) - 2) : S - 128 - 128 * ((kk) - 2); \
            _Pragma("unroll") for (int j_ = 0; j_ < 2; ++j_) { const int p_ = tid + 512 * j_, s_ = p_ >> 3, c8_ = p_ & 7, tt_ = tl_ + (dir == 0 ? s_ : 127 - s_); \
                const unsigned ob_ = (unsigned)(tt_ * 128 + c8_ * 16); PT[j_] = *(const u32x4*)((const char*)partp + ob_); GT[j_] = *(const u32x4*)((const char*)glsp + ob_); } } while (0)
#define LRU_MERGE_STORE(kk) do { const int tl_ = dir == 0 ? 128 * ((kk) - 2) : S - 128 - 128 * ((kk) - 2); \
            _Pragma("unroll") for (int j_ = 0; j_ < 2; ++j_) { const int p_ = tid + 512 * j_, s_ = p_ >> 3, c8_ = p_ & 7, tt_ = tl_ + (dir == 0 ? s_ : 127 - s_); \
                const u32x4 ov_ = *(const LAS u32x4*)(lds + LRU_OUT + s_ * 128 + c8_ * 16); const int cm_ = n * BD + hc * 64 + c8_ * 8; \
                const f32x4 w0_ = *(const f32x4*)(a.in[I_ONL] + cm_), w1_ = *(const f32x4*)(a.in[I_ONL] + cm_ + 4); \
                float v_[8]; float ss_ = 0.f; \
                _Pragma("unroll") for (int e_ = 0; e_ < 4; ++e_) { v_[2 * e_] = bflo(ov_[e_]) + bflo(PT[j_][e_]); v_[2 * e_ + 1] = bfhi(ov_[e_]) + bfhi(PT[j_][e_]); ss_ += v_[2 * e_] * v_[2 * e_] + v_[2 * e_ + 1] * v_[2 * e_ + 1]; } \
                ss_ += __shfl_xor(ss_, 1); ss_ += __shfl_xor(ss_, 2); ss_ += __shfl_xor(ss_, 4); \
                u32x4 oo_; \
                oo_[0] = pk2(v_[0] * w0_[0] * bflo(GT[j_][0]), v_[1] * w0_[1] * bfhi(GT[j_][0])); oo_[1] = pk2(v_[2] * w0_[2] * bflo(GT[j_][1]), v_[3] * w0_[3] * bfhi(GT[j_][1])); \
                oo_[2] = pk2(v_[4] * w1_[0] * bflo(GT[j_][2]), v_[5] * w1_[1] * bfhi(GT[j_][2])); oo_[3] = pk2(v_[6] * w1_[2] * bflo(GT[j_][3]), v_[7] * w1_[3] * bfhi(GT[j_][3])); \
                const unsigned row_ = (unsigned)(b * S + tt_); \
                *(u32x4*)((char*)(a.ws + WS_MIX) + (unsigned)((row_ * (unsigned)DMIX + (unsigned)(DATT + cm_)) * 2u)) = oo_; \
                if (c8_ == 0) *(float*)((char*)(a.ws + WS_SSQL) + (unsigned)((row_ * 32u + (unsigned)(n * 2 + hc)) * 4u)) = ss_; } } while (0)
        __syncthreads();
        LRU_LOAD(0);
#define LRU_RAWPUT(kk) do { const int rb_ = ((kk) & 1) ? LRU_RAW2 : LRU_RAW; \
            _Pragma("unroll") for (int ps = 0; ps < 5; ++ps) { const int r_ = lrow + 32 * ps; if (r_ < 132) *(LAS u32x4*)(lds + rb_ + r_ * 256 + lc * 16) = R[ps]; } } while (0)
        LRU_RAWPUT(0); LRU_BAR(); LRU_LOAD(1);
        for (int k = 0; k < 18; ++k) {
            if (k == 10) asm volatile("s_waitcnt vmcnt(0)" ::: "memory");
            const bool isc = k < 2; const int pl0 = isc ? 128 * k : 128 * (k - 2), len = isc ? C : S; const int tlo = dir == 0 ? pl0 : len - 128 - pl0;
            const int rawb = (k & 1) ? LRU_RAW2 : LRU_RAW;
            const bool flag10 = (k == 10 && tid == 0);
            if (k == 12) {
                if (tid == 0) { unsigned* pf = (unsigned*)(a.ws + WS_CTL) + CW_LRUF + (item ^ 32) * 16; unsigned sp = 0;
                    while (__hip_atomic_load(pf, __ATOMIC_RELAXED, __HIP_MEMORY_SCOPE_AGENT) == 0u && ++sp < (1u << 22)) __builtin_amdgcn_s_sleep(2);
                    __builtin_amdgcn_fence(__ATOMIC_ACQUIRE, "agent"); asm volatile("s_waitcnt vmcnt(0)" ::: "memory"); }
                LRU_BAR(); }
            u32x4 PT[2], GT[2];
            if (k >= 12) LRU_MERGE_LOAD(k - 1);
            { f32x2 xr[19];
#pragma unroll
              for (int rr = 0; rr < 19; ++rr) { const unsigned v = *(const LAS unsigned*)(lds + rawb + (16 * w + rr) * 256 + lane * 4); xr[rr] = (f32x2){bflo(v), bfhi(v)}; }
#pragma unroll
              for (int e = 0; e < 16; ++e) { const int i = 16 * w + e, s = dir == 0 ? i : 127 - i, key = (((s >> 4) & 3) << 2) | (s & 3);
                  const f32x2 u = cbv + cwv[0] * xr[e] + cwv[1] * xr[e + 1] + cwv[2] * xr[e + 2] + cwv[3] * xr[e + 3];
                  *(LAS unsigned*)(lds + LRU_UA + s * 256 + ((((2 * lane) >> 3) ^ key) << 4) + ((2 * lane) & 7) * 2) = pg8::cvt_pk_bf16(u[0], u[1]);
                  if (own) *(LAS f32x2*)(lds + LRU_UF + s * 256 + (2 * (lane & 31)) * 4) = u; } }
            LRU_BAR();
            if (flag10) __hip_atomic_store((unsigned*)(a.ws + WS_CTL) + CW_LRUF + item * 16, 1u, __ATOMIC_RELAXED, __HIP_MEMORY_SCOPE_AGENT);
            if (k >= 3 && k < 12) LRU_COPYOUT(k - 1);
            f32x4 ar[4], ai[4];
#pragma unroll
            for (int m = 0; m < 4; ++m) { ar[m] = (f32x4){0.f, 0.f, 0.f, 0.f}; ai[m] = (f32x4){0.f, 0.f, 0.f, 0.f}; }
#pragma unroll
            for (int ks = 0; ks < 4; ++ks)
#pragma unroll
                for (int m = 0; m < 4; ++m) { const int s = 64 * th + 16 * (c16 >> 2) + 4 * m + (c16 & 3);
                    const bf16x8_t af = *(const LAS bf16x8_t*)(lds + LRU_UA + s * 256 + (((4 * ks + g) ^ c16) << 4));
                    ar[m] = __builtin_amdgcn_mfma_f32_16x16x32_bf16(af, Bwa[ks], ar[m], 0, 0, 0);
                    ai[m] = __builtin_amdgcn_mfma_f32_16x16x32_bf16(af, Bwx[ks], ai[m], 0, 0, 0); }
            float Ac = 1.f, Hl = 0.f; f32x2 AcT[4][2], HlT[4][2];
#pragma unroll
            for (int m = 0; m < 4; ++m)
#pragma unroll
                for (int hp = 0; hp < 2; ++hp) { const int s = 64 * th + 16 * g + 4 * m + 2 * hp;
                    const f32x2 uu = (f32x2){*(const LAS float*)(lds + LRU_UF + s * 256 + (16 * cgq + c16) * 4), *(const LAS float*)(lds + LRU_UF + (s + 1) * 256 + (16 * cgq + c16) * 4)};
                    const f32x2 x1 = (f32x2){ar[m][2 * hp], ar[m][2 * hp + 1]} * (-L2E) + nba, x2 = (f32x2){ai[m][2 * hp], ai[m][2 * hp + 1]} * (-L2E) + nbx;
                    const f32x2 d1 = (f32x2){__builtin_amdgcn_exp2f(x1[0]), __builtin_amdgcn_exp2f(x1[1])} + 1.0f, d2 = (f32x2){__builtin_amdgcn_exp2f(x2[0]), __builtin_amdgcn_exp2f(x2[1])} + 1.0f;
                    const f32x2 rg = (f32x2){__builtin_amdgcn_rcpf(d1[0]), __builtin_amdgcn_rcpf(d1[1])}, ig = (f32x2){__builtin_amdgcn_rcpf(d2[0]), __builtin_amdgcn_rcpf(d2[1])};
                    const f32x2 ea = rg * cav; const f32x2 av = (f32x2){__builtin_amdgcn_exp2f(ea[0]), __builtin_amdgcn_exp2f(ea[1])};
                    const f32x2 t = rg * sp16, qf = t * (1.0f + t * (-0.5f + t * ((1.0f / 6) + t * ((-1.0f / 24) + t * (1.0f / 120))))), qg = 1.0f - av * av;
                    const f32x2 q1 = (f32x2){t[0] < 0.25f ? qf[0] : qg[0], t[1] < 0.25f ? qf[1] : qg[1]};
                    const f32x2 bv = (f32x2){__builtin_amdgcn_sqrtf(q1[0]), __builtin_amdgcn_sqrtf(q1[1])} * (ig * uu);
                    f32x2 Ao, Ho;
                    Ac *= av[0]; Hl = av[0] * Hl + bv[0]; Ao[0] = Ac; Ho[0] = Hl;
                    Ac *= av[1]; Hl = av[1] * Hl + bv[1]; Ao[1] = Ac; Ho[1] = Hl;
                    AcT[m][hp] = Ao; HlT[m][hp] = Ho; if (hp == 1) __builtin_amdgcn_sched_barrier(0); }
            float As = Ac, Hs = Hl;
            { float Ap = __shfl_up(As, 16), Hp = __shfl_up(Hs, 16); if (g >= 1) { Hs = As * Hp + Hs; As = As * Ap; } }
            { float Ap = __shfl_up(As, 32), Hp = __shfl_up(Hs, 32); if (g >= 2) { Hs = As * Hp + Hs; As = As * Ap; } }
            float Ae = __shfl_up(As, 16), He = __shfl_up(Hs, 16); if (g == 0) { Ae = 1.f; He = 0.f; }
            const float A3 = __shfl(As, 48 + c16), H3 = __shfl(Hs, 48 + c16);
            { typedef float f32x2 __attribute__((ext_vector_type(2)));
              if (g == 0) *(LAS f32x2*)(lds + LRU_XCH + ((th * 4 + cgq) * 16 + c16) * 8) = (f32x2){A3, H3};
              if (k >= 12) LRU_MERGE_STORE(k - 1);
              if (k + 1 < 18) LRU_RAWPUT(k + 1);
              LRU_BAR();
              if (k + 2 < 18) LRU_LOAD(k + 2);
              const f32x2 pp = *(const LAS f32x2*)(lds + LRU_XCH + (((th ^ 1) * 4 + cgq) * 16 + c16) * 8);
              float cw_;
              if (th == 0) { cw_ = h_in; h_in = pp[0] * (A3 * h_in + H3) + pp[1]; }
              else         { cw_ = pp[0] * h_in + pp[1]; h_in = A3 * cw_ + H3; }
              const float cin = Ae * cw_ + He;
              if (!isc) {
#pragma unroll
                  for (int m = 0; m < 4; ++m)
#pragma unroll
                      for (int hp = 0; hp < 2; ++hp) { const int s = 64 * th + 16 * g + 4 * m + 2 * hp; const f32x2 hv = HlT[m][hp] + AcT[m][hp] * cin;
                          const unsigned pk = pg8::cvt_pk_bf16(hv[0], hv[1]);
                          *(LAS bf16*)(lds + LRU_OUT + s * 128 + (16 * cgq + c16) * 2) = (bf16)(pk & 0xffffu); *(LAS bf16*)(lds + LRU_OUT + (s + 1) * 128 + (16 * cgq + c16) * 2) = (bf16)(pk >> 16); }
              } }
        }
        __syncthreads(); { u32x4 PT[2], GT[2]; LRU_MERGE_LOAD(17); LRU_MERGE_STORE(17); }
        asm volatile("s_waitcnt vmcnt(0)" ::: "memory");
        __syncthreads();
        { LAS unsigned* flag = (LAS unsigned*)(lds + LRU_XCH);
          if (tid == 0) {
              const unsigned old_ = __hip_atomic_fetch_add((unsigned*)(a.ws + WS_CTL) + CW_LRU + ((b * NBLK + n) * 2 + hc) * 16, 1u, __ATOMIC_RELAXED, __HIP_MEMORY_SCOPE_AGENT);
              if (old_ == 1u) { __builtin_amdgcn_fence(__ATOMIC_ACQUIRE, "agent"); asm volatile("s_waitcnt vmcnt(0)" ::: "memory"); }
              *flag = old_; }
          __syncthreads();
          if (*flag == 1u) { int tq = tid; asm volatile("" : "+v"(tq)); lru_merge_slice<4>(a, b, n, hc, tq, 7 * 128, 4); } }
#undef LRU_LOAD
#undef LRU_RAWPUT
#undef LRU_COPYOUT
#undef LRU_MERGE_LOAD
#undef LRU_MERGE_STORE
#undef LRU_BAR
    }
}
struct InProjOrder {
    pg8::StaticOrder so; int G, c; const unsigned* ready; int need;
    __device__ void init(int G_, int c_, const unsigned* ready_, int need_) { so.init(MX, DIN, G_, c_); G = G_; c = c_; ready = ready_; need = need_; }
    __device__ bool next(int i, pg8::Unit& u) const {
        const int L = i * G + c;
        if (L < 1152) return so.next(i, u);
        if (L >= 1200) return false;
        const int idx = L - 1152, j = idx >> 2; u.pm = 32 + (idx & 3); u.pn = j < 4 ? 8 + j : 16 + j; u.ui = i; return true;
    }
    __device__ __forceinline__ void a_ready(const pg8::Unit& u) const {
        if (need == 0) return;
        if (threadIdx.x < 64 && !tile_is_early(u.pn)) {
            unsigned polls = 0;
            while ((unsigned)__builtin_amdgcn_readfirstlane(__hip_atomic_load(ready + 16 * u.pn, __ATOMIC_RELAXED, __HIP_MEMORY_SCOPE_AGENT)) < (unsigned)need) { if (++polls > (1u << 22)) break; __builtin_amdgcn_s_sleep(2); }
            __builtin_amdgcn_fence(__ATOMIC_ACQUIRE, "agent");
            asm volatile("s_waitcnt vmcnt(0)" ::: "memory");
        }
        asm volatile("" ::: "memory"); __builtin_amdgcn_s_barrier(); asm volatile("" ::: "memory");
    }
    __device__ __forceinline__ void done(const pg8::Unit&) const {}
};
struct EpiInProj {
    static constexpr bool PERM = true, AFTER_DRAIN = false, MIDSCALE = false;
    bf16 *Qb, *Kb, *Vb, *GA, *XL, *GL; const float *qnw, *knw, *ct, *st; LAS float* xs;
    __device__ __forceinline__ static u32x4 pack8(const f32x4& v0, const f32x4& v1) {
        u32x4 w; w.x = pg8::cvt_pk_bf16(v0[0], v0[1]); w.y = pg8::cvt_pk_bf16(v0[2], v0[3]); w.z = pg8::cvt_pk_bf16(v1[0], v1[1]); w.w = pg8::cvt_pk_bf16(v1[2], v1[3]); return w; }
    __device__ __forceinline__ void operator()(const f32x4 (&acc)[2][2][4][2], const pg8::Unit& u, int wr, int wc, int fr, int fq) const {
        const int pn = u.pn, pm = u.pm; const bool isx = pm < 32;
        const int colw = wc * 32 + 8 * fq;
        const size_t kvrow0 = isx ? (size_t)(pm >> 3) * SKV + (size_t)(pm & 7) * 256 : (size_t)(pm - 32) * SKV + S;
        if (pn < 10) {
            const bool isq = pn < 8;
#pragma unroll
            for (int ai = 0; ai < 2; ++ai)
#pragma unroll
                for (int bj = 0; bj < 2; ++bj)
#pragma unroll
                    for (int m = 0; m < 4; ++m) { const f32x4 v0 = acc[ai][bj][m][0], v1 = acc[ai][bj][m][1];
                        float s = (v0[0] * v0[0] + v0[1] * v0[1]) + (v0[2] * v0[2] + v0[3] * v0[3]) + (v1[0] * v1[0] + v1[1] * v1[1]) + (v1[2] * v1[2] + v1[3] * v1[3]);
                        s += __shfl_xor(s, 16); s += __shfl_xor(s, 32);
                        if (fq == 0) xs[(((wr * 2 + bj) * 128) + ai * 64 + m * 16 + fr) * 4 + wc] = s; }
            asm volatile("s_waitcnt lgkmcnt(0)" ::: "memory"); __builtin_amdgcn_s_barrier(); asm volatile("" ::: "memory");
            const int a_ = wc >> 1, f0 = (wc & 1) * 16 + fq * 4;
            const float* nw = isq ? qnw : knw;
            const f32x4 w0 = *(const f32x4*)(nw + a_ * 64 + f0), w1 = *(const f32x4*)(nw + a_ * 64 + 32 + f0);
#pragma unroll
            for (int ai = 0; ai < 2; ++ai)
#pragma unroll
                for (int m = 0; m < 4; ++m) { const int rt = ai * 128 + wr * 64 + m * 16 + fr;
                    f32x4 cs = (f32x4){1.f, 1.f, 1.f, 1.f}, sn = (f32x4){0.f, 0.f, 0.f, 0.f};
                    if (isx) { const int t = (pm & 7) * 256 + rt, pos = a_ == 0 ? (t >> 6) : (t & 63); cs = *(const f32x4*)(ct + pos * 32 + f0); sn = *(const f32x4*)(st + pos * 32 + f0); }
#pragma unroll
                    for (int bj = 0; bj < 2; ++bj) {
                        const f32x4 p = *(const LAS f32x4*)(xs + (((wr * 2 + bj) * 128) + ai * 64 + m * 16 + fr) * 4);
                        const float rstd = 1.0f / sqrtf(((p[0] + p[1]) + (p[2] + p[3])) * (1.0f / HD) + EPS);
                        const f32x4 x1 = acc[ai][bj][m][0] * rstd * w0, x2 = acc[ai][bj][m][1] * rstd * w1;
                        const f32x4 o1 = x1 * cs - x2 * sn, o2 = x2 * cs + x1 * sn;
                        bf16* dst = isq ? Qb + (size_t)(pm * 256 + rt) * DATT + pn * 256 + bj * 128 + colw
                                        : Kb + (kvrow0 + rt) * DKV + (pn - 8) * 256 + bj * 128 + colw;
                        *(u32x4*)dst = pack8(o1, o2); } }
        } else if (pn < 12) {
#pragma unroll
            for (int ai = 0; ai < 2; ++ai)
#pragma unroll
                for (int m = 0; m < 4; ++m) { const int rt = ai * 128 + wr * 64 + m * 16 + fr;
#pragma unroll
                    for (int bj = 0; bj < 2; ++bj) *(u32x4*)(Vb + (kvrow0 + rt) * DKV + (pn - 10) * 256 + bj * 128 + colw) = pack8(acc[ai][bj][m][0], acc[ai][bj][m][1]); }
        } else if (pn >= 20 && pn < 28) {
#pragma unroll
            for (int ai = 0; ai < 2; ++ai)
#pragma unroll
                for (int m = 0; m < 4; ++m) { const int rt = ai * 128 + wr * 64 + m * 16 + fr;
#pragma unroll
                    for (int bj = 0; bj < 2; ++bj) *(u32x4*)(XL + (size_t)(pm * 256 + rt) * DLRU + (pn - 20) * 256 + bj * 128 + colw) = pack8(acc[ai][bj][m][0], acc[ai][bj][m][1]); }
        } else {
            const bool isga = pn < 20;
#pragma unroll
            for (int ai = 0; ai < 2; ++ai)
#pragma unroll
                for (int m = 0; m < 4; ++m) { const int rt = ai * 128 + wr * 64 + m * 16 + fr;
#pragma unroll
                    for (int bj = 0; bj < 2; ++bj) { f32x4 v0 = acc[ai][bj][m][0], v1 = acc[ai][bj][m][1];
#pragma unroll
                        for (int e = 0; e < 4; ++e) { v0[e] = v0[e] * __builtin_amdgcn_rcpf(1.0f + __expf(-v0[e])); v1[e] = v1[e] * __builtin_amdgcn_rcpf(1.0f + __expf(-v1[e])); }
                        bf16* dst = isga ? GA + (size_t)(pm * 256 + rt) * DATT + (pn - 12) * 256 + bj * 128 + colw
                                         : GL + ((size_t)((((pm >> 3) * NBLK + (pn - 28) * 2 + bj) * 2 + (colw >> 6)) * S) + (pm & 7) * 256 + rt) * 64 + (colw & 63);
                        *(u32x4*)dst = pack8(v0, v1); } }
        }
    }
};
typedef __attribute__((address_space(1))) unsigned gu32;
constexpr int CW_BAR = 4096;
constexpr size_t CTL_ZERO_BYTES = 128 * 1024;
#define XB_TMO      128
#define XB_XCNT(j)  (256  + 64 * (j))
#define XB_XSUB(j)  (1280 + 64 * (j))
#define XB_XGEN(j)  (2304 + 64 * (j))
#define XB_TOP      3328
#define XB_TOPGEN   3392
#define XCD_BAR_WORDS 3456
#define XB_SPIN_CAP (1u << 18)

__device__ __forceinline__ unsigned xb_ld(unsigned* p)              { return __hip_atomic_load(p, __ATOMIC_RELAXED, __HIP_MEMORY_SCOPE_AGENT); }
__device__ __forceinline__ unsigned xb_add(unsigned* p, unsigned v) { return __hip_atomic_fetch_add(p, v, __ATOMIC_RELAXED, __HIP_MEMORY_SCOPE_AGENT); }
__device__ __forceinline__ unsigned xb_xcc_id() { return (unsigned)__builtin_amdgcn_s_getreg((3 << 11) | 20) & 0xFu; }
#define XB_SPIN(cond, bar) do { unsigned _sp = 0; while (cond) { __builtin_amdgcn_s_sleep(1); \
    if ((++_sp & 255u) == 0u) { if (xb_ld(&(bar)[XB_TMO])) break; if (_sp > XB_SPIN_CAP) { atomicAdd(&(bar)[XB_TMO], 1u); break; } } } } while (0)

struct XcdBarrier {
    unsigned* bar; unsigned x;
    volatile LAS unsigned* st;
};

__device__ __forceinline__ XcdBarrier xcd_barrier_post(unsigned* bar, volatile LAS unsigned* st) {
    XcdBarrier b; b.bar = bar; b.x = xb_xcc_id(); b.st = st;
    if (threadIdx.x == 0) (void)xb_add(&bar[XB_XCNT(b.x)], 1u);
    return b;
}
__device__ __forceinline__ void xcd_barrier_complete(unsigned* bar, unsigned x, unsigned& nloc, unsigned& nx) {
    const unsigned G = gridDim.x * gridDim.y * gridDim.z;
    unsigned sum, cnt, mine, sp = 0u;
    for (;;) {
        sum = 0u; cnt = 0u; mine = 0u;
#pragma unroll
        for (unsigned j = 0; j < 16; ++j) { const unsigned c = xb_ld(&bar[XB_XCNT(j)]); sum += c; cnt += (c > 0u) ? 1u : 0u; mine = (j == x) ? c : mine; }
        if (sum == G) break;
        __builtin_amdgcn_s_sleep(1);
        if ((++sp & 255u) == 0u) { if (xb_ld(&bar[XB_TMO])) break; if (sp > XB_SPIN_CAP) { atomicAdd(&bar[XB_TMO], 1u); break; } }
    }
    nloc = mine > 0u ? mine : 1u; nx = cnt > 0u ? cnt : 1u;
}

__device__ __forceinline__ void xcd_barrier(const XcdBarrier& b) {
    asm volatile("s_waitcnt vmcnt(0)" ::: "memory");
    __syncthreads();
    if (threadIdx.x == 0) {
        unsigned* bar = b.bar;
        __builtin_amdgcn_s_waitcnt(0);
        unsigned nloc = b.st[0], nx = b.st[1];
        if (nloc == 0u) { xcd_barrier_complete(bar, b.x, nloc, nx); b.st[0] = nloc; b.st[1] = nx; }
        const unsigned old = xb_add(&bar[XB_XSUB(b.x)], 1u);
        const unsigned gen = old / nloc;
        if (old + 1u == (gen + 1u) * nloc) {
            __builtin_amdgcn_fence(__ATOMIC_RELEASE, "agent");
            asm volatile("s_waitcnt vmcnt(0)" ::: "memory");
            const unsigned og = xb_add(&bar[XB_TOP], 1u);
            const unsigned tg = og / nx;
            if (og + 1u == (tg + 1u) * nx) xb_add(&bar[XB_TOPGEN], 1u);
            else XB_SPIN(xb_ld(&bar[XB_TOPGEN]) == tg, bar);
            __builtin_amdgcn_fence(__ATOMIC_ACQUIRE, "agent");
            xb_add(&bar[XB_XGEN(b.x)], 1u);
            asm volatile("s_waitcnt vmcnt(0)" ::: "memory");
        } else {
            XB_SPIN(xb_ld(&bar[XB_XGEN(b.x)]) == gen, bar);
            __builtin_amdgcn_fence(__ATOMIC_ACQUIRE, "agent");
            asm volatile("s_waitcnt vmcnt(0)" ::: "memory");
        }
    }
    __syncthreads();
}

constexpr int NPHASE = 6;
__global__ void __launch_bounds__(NTHREADS, 2) mk_fwd(Args a) {
    extern __shared__ __attribute__((aligned(16))) unsigned char lds[];
    const int bid = blockIdx.x, nb = gridDim.x;
    const int lo = a.ph_lo, hi = a.ph_hi;
#define IN(k) (lo <= (k) && (k) < hi)
#if MK_ONE_LAUNCH
    volatile LAS unsigned* MISC = (volatile LAS unsigned*)((LAS unsigned char*)lds + MISC_OFF);
    if (threadIdx.x < 64) MISC[threadIdx.x] = 0u;
    __syncthreads();
    const XcdBarrier bar = xcd_barrier_post((unsigned*)(a.ws + WS_CTL) + CW_BAR, MISC + 8);
#define SEAM(k) do { if (IN(k) && IN((k) + 1)) xcd_barrier(bar); } while (0)
#else
#define SEAM(k) do { } while (0)
#endif
    if (IN(0)) { phase_prep(a, (LAS unsigned char*)lds, bid, nb); } SEAM(0);
    if (IN(1)) { phase_norm(a, bid, nb); } SEAM(1);
    if (IN(2)) {
        const bool split = (nb == 256);
        if (split && bid >= nb - NPROD) producer_phase(a, (LAS unsigned char*)lds, bid - (nb - NPROD));
        else {
        pg8::Gemm g{(const pg8::bf16_t*)(a.ws + WS_H), (const pg8::bf16_t*)(a.ws + WS_WIN), MT, DIN, D}; InProjOrder So;
        So.init(split ? nb - NPROD : nb, bid, (const unsigned*)(a.ws + WS_CTL) + CW_TILE, split ? NPROD * NWAVES : 0);
        const float* ctp = (const float*)(a.ws + WS_ROPE);
        EpiInProj E{(bf16*)(a.ws + WS_Q), (bf16*)(a.ws + WS_K), (bf16*)(a.ws + WS_V), (bf16*)(a.ws + WS_GA), (bf16*)(a.ws + WS_XL), (bf16*)(a.ws + WS_GL),
                    a.in[I_QNW], a.in[I_KNW], ctp, ctp + 64 * 32, (LAS float*)((LAS unsigned char*)lds + XS_OFF)};
        pg8::gemm_phase<EpiInProj, InProjOrder, true, true>((PG8_LAS unsigned char*)lds, g, So, E);
        if (!split) { const int rem = 1200 % nb; if (rem == 0) wout_transpose(a, (LAS unsigned char*)lds, bid, nb); else if (bid >= rem) wout_transpose(a, (LAS unsigned char*)lds, bid - rem, nb - rem); }
        }
    } SEAM(2);
    const int vb = (nb % 8 == 0) ? (bid % 8) * (nb / 8) + bid / 8 : bid;
    if (IN(3)) { phase_lru(a, (LAS unsigned char*)lds, vb, nb); __syncthreads(); }
    if (IN(4)) { phase_attn(a, (char*)lds, vb, nb); } SEAM(4);
    if (IN(5)) {
        pg8::Gemm g{(const pg8::bf16_t*)(a.ws + WS_MIX), (const pg8::bf16_t*)(a.ws + WS_WOUT), MX, D, DMIX}; pg8::StaticOrder So; So.init(MX, D, nb, bid);
        { LAS float* ftab = (LAS float*)((LAS unsigned char*)lds + XS_OFF); const float* SSQA = (const float*)(a.ws + WS_SSQA); const float* SSQL = (const float*)(a.ws + WS_SSQL);
          const int t_ = threadIdx.x, r_ = t_ & 255, part = t_ >> 8;
#pragma unroll 1
          for (int i = 0; i < 4; ++i) { pg8::Unit u; if (!So.next(i, u)) break; const size_t row = (size_t)u.pm * 256 + r_; float s = 0.f;
              if (part == 0) {
#pragma unroll
                  for (int j = 0; j < 4; ++j) { const f32x4 q = *(const f32x4*)(SSQA + row * 16 + 4 * j); s += (q[0] + q[1]) + (q[2] + q[3]); }
                  ftab[(i * 256 + r_) * 2] = 1.0f / sqrtf(s * (1.0f / DATT) + EPS); }
              else {
#pragma unroll
                  for (int j = 0; j < 8; ++j) { const f32x4 q = *(const f32x4*)(SSQL + row * 32 + 4 * j); s += (q[0] + q[1]) + (q[2] + q[3]); }
                  ftab[(i * 256 + r_) * 2 + 1] = 1.0f / sqrtf(s * (1.0f / DLRU) + EPS); } }
          __syncthreads(); }
        pg8::EpiResid E{a.in[I_X], a.out, D, (const float*)(a.ws + WS_MOD) + 2 * D, DMOD, S, (const PG8_LAS float*)((PG8_LAS unsigned char*)lds + XS_OFF)};
        pg8::gemm_phase<pg8::EpiResid, pg8::StaticOrder, true, true>((PG8_LAS unsigned char*)lds, g, So, E);
    }
#undef IN
#undef SEAM
}
}

extern "C" void kernel_launch(void* const* d_in, const int* in_sizes, int n_in, void* d_out, int out_size, void* d_ws, size_t ws_size, hipStream_t stream) {
    using namespace mk;
    static int grid = 0;
    if (grid == 0) {
        if (n_in != 20 || in_sizes[0] != MX * D || out_size != MX * D || ws_size < WS_END) { fprintf(stderr, "kernel_launch: unexpected shapes (n_in %d, in0 %d, out %d, ws %zu)\n", n_in, n_in > 0 ? in_sizes[0] : -1, out_size, ws_size); grid = -1; return; }
        int dev = 0, cus = 0, per_cu = 0;
        (void)hipGetDevice(&dev); (void)hipDeviceGetAttribute(&cus, hipDeviceAttributeMultiprocessorCount, dev);
        if (hipFuncSetAttribute((const void*)mk_fwd, hipFuncAttributeMaxDynamicSharedMemorySize, LDS_BYTES) != hipSuccess) { fprintf(stderr, "kernel_launch: hipFuncSetAttribute failed\n"); grid = -1; return; }
        (void)hipOccupancyMaxActiveBlocksPerMultiprocessor(&per_cu, (const void*)mk_fwd, NTHREADS, LDS_BYTES);
        if (per_cu < 1) { fprintf(stderr, "kernel_launch: occupancy query says %d blocks per CU\n", per_cu); per_cu = 1; }
        (void)hipGetLastError();
        grid = cus;
    }
    if (grid < 0) return;
    Args a{};
    for (int i = 0; i < 20; ++i) a.in[i] = (const float*)d_in[i];
    a.out = (float*)d_out; a.ws = (unsigned char*)d_ws;
#if MK_ONE_LAUNCH
    a.ph_lo = 0; a.ph_hi = NPHASE;
    if (hipMemsetAsync((char*)d_ws + WS_CTL, 0, CTL_ZERO_BYTES, stream) != hipSuccess) { fprintf(stderr, "kernel_launch: memset failed\n"); return; }
    hipLaunchKernelGGL(mk_fwd, dim3(grid), dim3(NTHREADS), LDS_BYTES, stream, a);
    const hipError_t le = hipPeekAtLastError();
    if (le != hipSuccess) fprintf(stderr, "kernel_launch: launch failed: %s\n", hipGetErrorName(le));
#else
    for (int p = 0; p < NPHASE; ++p) {
        a.ph_lo = p; a.ph_hi = p + 1;
        hipLaunchKernelGGL(mk_fwd, dim3(grid), dim3(NTHREADS), LDS_BYTES, stream, a);
    }
    const hipError_t le = hipPeekAtLastError();
    if (le != hipSuccess) fprintf(stderr, "kernel_launch: launch failed: %s\n", hipGetErrorName(le));
#endif
}
```

```cpp
#include <hip/hip_runtime.h>
#include <hip/hip_bf16.h>
#include <hip/hip_cooperative_groups.h>
#include <cstdio>
#include <cstdint>
namespace pg8 {
#define PG8_LAS __attribute__((address_space(3)))
typedef unsigned short bf16_t;
typedef short bf16x8 __attribute__((ext_vector_type(8)));
typedef float f32x4 __attribute__((ext_vector_type(4)));
typedef unsigned u32x4 __attribute__((ext_vector_type(4)));
constexpr int BM = 256, BK = 64, HALF = 128, HTB = HALF * BK * 2  , STAGE_BYTES = 8 * HTB, NXCD = 8, WGM = 8;

__host__ __device__ __forceinline__ int lds_byte(int r, int c) { const int st = (r >> 4) * 2 + (c >> 5), rr = r & 15, cc = c & 31, ob = rr * 64 + cc * 2; return st * 1024 + (ob ^ (((ob >> 9) & 1) << 5)); }
__host__ __device__ __forceinline__ void stage_rc(int b, int& R, int& C) { const int st = b / 1024, sb = b % 1024, swz = sb ^ (((sb >> 9) & 1) << 5); R = (st >> 1) * 16 + swz / 64; C = (st & 1) * 32 + (swz % 64) / 2; }
__host__ __device__ __forceinline__ int perm32(int rho) { const int n = rho >> 4, i = rho & 15; return 8 * (i >> 2) + 4 * n + (i & 3); }

struct Unit { int pm, pn, ui; };
struct Gemm { const bf16_t* A; const bf16_t* Bt; int M, N, K; };

struct StaticOrder {
    int nM, nN, nwg, G, c;
    __host__ __device__ void init(int M, int N, int G_, int c_) { nM = M / BM; nN = N / BM; nwg = nM * nN; G = G_; c = c_; }
    __host__ __device__ bool next(int i, Unit& u) const {
        const long L = (long)i * G + c; if (L >= nwg) return false;
        int wgid = (int)L; { const int q = nwg / NXCD, r = nwg % NXCD, xcd = wgid % NXCD, off = wgid / NXCD; wgid = (xcd < r ? xcd * (q + 1) : r * (q + 1) + (xcd - r) * q) + off; }
        const int nig = WGM * nN, gid = wgid / nig, fm = gid * WGM, gsz = (nM - fm) < WGM ? (nM - fm) : WGM;
        u.pm = fm + ((wgid % nig) % gsz); u.pn = (wgid % nig) / gsz; u.ui = i; return true;
    }
    __device__ __forceinline__ void a_ready(const Unit&) const {}
    __device__ __forceinline__ void done(const Unit&) const {}
};

__device__ __forceinline__ unsigned cvt_pk_bf16(float lo, float hi) { unsigned r; asm volatile("v_cvt_pk_bf16_f32 %0, %1, %2" : "=v"(r) : "v"(lo), "v"(hi)); return r; }
struct EpiBf16 {
    static constexpr bool PERM = true, AFTER_DRAIN = false, MIDSCALE = false;
    bf16_t* O; int ldc;
    __device__ __forceinline__ void operator()(const f32x4 (&acc)[2][2][4][2], const Unit& u, int wr, int wc, int fr, int fq) const {
        const int row0 = u.pm * BM + wr * 64 + fr; const int col0 = u.pn * BM + wc * 32 + 8 * fq;
#pragma unroll
        for (int ai = 0; ai < 2; ++ai)
#pragma unroll
            for (int m = 0; m < 4; ++m) { bf16_t* rowp = O + (size_t)(row0 + ai * HALF + m * 16) * ldc + col0;
#pragma unroll
                for (int bj = 0; bj < 2; ++bj) { const f32x4 v0 = acc[ai][bj][m][0], v1 = acc[ai][bj][m][1];
                    u32x4 w; w.x = cvt_pk_bf16(v0[0], v0[1]); w.y = cvt_pk_bf16(v0[2], v0[3]); w.z = cvt_pk_bf16(v1[0], v1[1]); w.w = cvt_pk_bf16(v1[2], v1[3]);
                    *(u32x4*)(rowp + bj * HALF) = w; } }
    }
};
struct EpiResid {
    static constexpr bool PERM = false, AFTER_DRAIN = false, MIDSCALE = true;
    const float* base; float* out; int ldc; const float* gate; int gate_ld; int rows_per_batch; const PG8_LAS float* ftab;
    __device__ __forceinline__ void midscale(f32x4 (&acc)[2][2][4][2], const Unit& u, int wr, int fr) const {
        const PG8_LAS float* ft = ftab + (u.ui & 3) * 512;
#pragma unroll
        for (int ai = 0; ai < 2; ++ai)
#pragma unroll
            for (int m = 0; m < 4; ++m) { const int rt = ai * HALF + wr * 64 + m * 16 + fr; const float ra = ft[rt * 2], rl = ft[rt * 2 + 1], q = ra / rl;
#pragma unroll
                for (int bj = 0; bj < 2; ++bj)
#pragma unroll
                    for (int n = 0; n < 2; ++n) acc[ai][bj][m][n] = acc[ai][bj][m][n] * q; }
    }
    __device__ __forceinline__ void operator()(const f32x4 (&acc)[2][2][4][2], const Unit& u, int wr, int wc, int fr, int fq) const {
        const int row0 = u.pm * BM + wr * 64 + fr, col0 = u.pn * BM + wc * 32 + 4 * fq;
        const float* g = gate + (size_t)((u.pm * BM) / rows_per_batch) * gate_ld + col0;
        const PG8_LAS float* ft = ftab + (u.ui & 3) * 512;
        f32x4 gv[2][2];
#pragma unroll
        for (int bj = 0; bj < 2; ++bj)
#pragma unroll
            for (int n = 0; n < 2; ++n) gv[bj][n] = *(const f32x4*)(g + bj * HALF + n * 16);
#pragma unroll
        for (int ai = 0; ai < 2; ++ai)
#pragma unroll
            for (int m = 0; m < 4; ++m) { const size_t off = (size_t)(row0 + ai * HALF + m * 16) * ldc + col0; const float rs = ft[(ai * HALF + wr * 64 + m * 16 + fr) * 2 + 1];
#pragma unroll
                for (int bj = 0; bj < 2; ++bj)
#pragma unroll
                    for (int n = 0; n < 2; ++n) { const f32x4 bs = *(const f32x4*)(base + off + bj * HALF + n * 16);
                        *(f32x4*)(out + off + bj * HALF + n * 16) = bs + gv[bj][n] * (acc[ai][bj][m][n] * rs); } }
    }
};
template <class Epi, class Sched, bool ALIGN_EPI = false, bool SP2 = false>
__device__ __forceinline__ void gemm_phase(PG8_LAS unsigned char* lds, const Gemm g, const Sched& S, const Epi& E) {
    const int tid = threadIdx.x, wid = __builtin_amdgcn_readfirstlane(tid >> 6), lane = tid & 63, wr = wid >> 2, wc = wid & 3, fr = lane & 15, fq = lane >> 4;
    const int K = g.K, nt = K / BK;
    unsigned voffA[2], voffB[2];
#pragma unroll
    for (int i = 0; i < 2; ++i) { int R, C; stage_rc(tid * 16 + i * 8192, R, C); const int Rb = Epi::PERM ? ((R & ~31) + perm32(R & 31)) : R;
        voffA[i] = (unsigned)(R * K + C) * 2u; voffB[i] = (unsigned)(Rb * K + C) * 2u; }
    const size_t kstep = (size_t)(BK * 2);
    const size_t hstep = (size_t)HALF * K * 2;
    const size_t tstep = 2 * hstep;
    const unsigned ldsw = (unsigned)wid * 1024u;
    const int aoff = lds_byte(wr * 64 + fr, fq * 8), boff = lds_byte(wc * 32 + fr, fq * 8);
#define PG8_SA(b, h) (((b) * 2 + (h)) * HTB)
#define PG8_SB(b, h) ((4 + (b) * 2 + (h)) * HTB)
#define PG8_STAGE(bufoff, gbase, voff) do { _Pragma("unroll") for (int _i = 0; _i < 2; ++_i) \
        __builtin_amdgcn_global_load_lds((const unsigned*)((const char*)(gbase) + (voff)[_i]), (PG8_LAS unsigned*)(lds + (bufoff) + ldsw + _i * 8192), 16, 0, 0); } while (0)
#define PG8_LDA(dst, b, h) do { _Pragma("unroll") for (int m = 0; m < 4; ++m) _Pragma("unroll") for (int k = 0; k < 2; ++k) dst[m][k] = *(const PG8_LAS bf16x8*)(lds + PG8_SA(b, h) + aoff + m * 2048 + k * 1024); } while (0)
#define PG8_LDB(dst, b, h) do { _Pragma("unroll") for (int n = 0; n < 2; ++n) _Pragma("unroll") for (int k = 0; k < 2; ++k) dst[n][k] = *(const PG8_LAS bf16x8*)(lds + PG8_SB(b, h) + boff + n * 2048 + k * 1024); } while (0)
#define PG8_MMA(ai, bj, At, Bt) do { __builtin_amdgcn_s_setprio(1); _Pragma("unroll") for (int m = 0; m < 4; ++m) _Pragma("unroll") for (int n = 0; n < 2; ++n) _Pragma("unroll") for (int k = 0; k < 2; ++k) \
        acc[ai][bj][m][n] = __builtin_amdgcn_mfma_f32_16x16x32_bf16(Bt[n][k], At[m][k], acc[ai][bj][m][n], 0, 0, 0); __builtin_amdgcn_s_setprio(0); } while (0)
#define PG8_WAIT_V(n) asm volatile("s_waitcnt vmcnt(" #n ")" ::: "memory")
#define PG8_WAIT_L(n) asm volatile("s_waitcnt lgkmcnt(" #n ")" ::: "memory")
#define PG8_BAR __builtin_amdgcn_s_barrier()
#define PG8_SCHED __builtin_amdgcn_sched_barrier(0)
    Unit cur, nxt; int ui = 0;
    if (!S.next(0, cur)) return;
    f32x4 acc[2][2][4][2];
#pragma unroll
    for (int a = 0; a < 2; ++a)
#pragma unroll
        for (int b = 0; b < 2; ++b)
#pragma unroll
            for (int m = 0; m < 4; ++m)
#pragma unroll
                for (int n = 0; n < 2; ++n) acc[a][b][m][n] = (f32x4){0.f, 0.f, 0.f, 0.f};
    bf16x8 At[4][2], B0[2][2], B1[2][2];
    const char* cA = (const char*)g.A + (size_t)cur.pm * tstep; const char* cB = (const char*)g.Bt + (size_t)cur.pn * tstep;
    S.a_ready(cur);
    if constexpr (SP2) {
        PG8_STAGE(PG8_SB(0, 0), cB, voffB); PG8_STAGE(PG8_SB(0, 1), cB + hstep, voffB); PG8_STAGE(PG8_SA(0, 0), cA, voffA); PG8_STAGE(PG8_SA(0, 1), cA + hstep, voffA);
        if (wr == 1) PG8_BAR;
        PG8_WAIT_V(2); PG8_BAR;
        PG8_STAGE(PG8_SB(1, 0), cB + kstep, voffB); PG8_STAGE(PG8_SA(1, 0), cA + kstep, voffA); PG8_STAGE(PG8_SB(1, 1), cB + hstep + kstep, voffB);
        PG8_WAIT_V(6); PG8_BAR;
    } else {
        PG8_STAGE(PG8_SB(0, 0), cB, voffB); PG8_STAGE(PG8_SA(0, 0), cA, voffA); PG8_STAGE(PG8_SB(0, 1), cB + hstep, voffB); PG8_STAGE(PG8_SA(0, 1), cA + hstep, voffA);
        if (wr == 1) PG8_BAR;
        PG8_WAIT_V(4); PG8_BAR;
        PG8_STAGE(PG8_SB(1, 0), cB + kstep, voffB); PG8_STAGE(PG8_SA(1, 0), cA + kstep, voffA); PG8_STAGE(PG8_SB(1, 1), cB + hstep + kstep, voffB);
        PG8_WAIT_V(6); PG8_BAR;
    }
    for (;;) {
        const bool has_next = S.next(ui + 1, nxt);
        const char* nA = has_next ? (const char*)g.A + (size_t)nxt.pm * tstep : cA; const char* nB = has_next ? (const char*)g.Bt + (size_t)nxt.pn * tstep : cB;
        for (int t = 0; t < nt; t += 2) {
            const bool last = (t == nt - 2);
            if constexpr (Epi::MIDSCALE) { if (t == (nt >> 1)) E.midscale(acc, cur, wr, fr); }
            const char* a1 = cA + (size_t)(t + 1) * kstep;
            const char* a2 = last ? nA : cA + (size_t)(t + 2) * kstep; const char* b2 = last ? nB : cB + (size_t)(t + 2) * kstep;
            const char* a3 = a2 + kstep; const char* b3 = b2 + kstep;
            if (last && has_next) S.a_ready(nxt);
            if constexpr (SP2) {
            PG8_LDB(B0, 0, 0); PG8_LDB(B1, 0, 1); PG8_SCHED; PG8_LDA(At, 0, 0); PG8_STAGE(PG8_SA(1, 1), a1 + hstep, voffA);
            PG8_WAIT_V(8); PG8_WAIT_L(0); PG8_BAR; PG8_MMA(0, 0, At, B0); PG8_MMA(0, 1, At, B1); PG8_BAR; PG8_SCHED;
            PG8_LDA(At, 0, 1); PG8_STAGE(PG8_SB(0, 0), b2, voffB); PG8_STAGE(PG8_SB(0, 1), b2 + hstep, voffB); PG8_STAGE(PG8_SA(0, 0), a2, voffA);
            PG8_WAIT_V(8); PG8_WAIT_L(0); PG8_BAR; PG8_MMA(1, 0, At, B0); PG8_MMA(1, 1, At, B1); PG8_BAR; PG8_SCHED;
            PG8_LDB(B0, 1, 0); PG8_LDB(B1, 1, 1); PG8_SCHED; PG8_LDA(At, 1, 0); PG8_STAGE(PG8_SA(0, 1), a2 + hstep, voffA);
            PG8_WAIT_V(8); PG8_WAIT_L(0); PG8_BAR; PG8_MMA(0, 0, At, B0); PG8_MMA(0, 1, At, B1); PG8_BAR; PG8_SCHED;
            PG8_LDA(At, 1, 1); PG8_STAGE(PG8_SB(1, 0), b3, voffB); PG8_STAGE(PG8_SB(1, 1), b3 + hstep, voffB); PG8_STAGE(PG8_SA(1, 0), a3, voffA);
            PG8_WAIT_V(8); PG8_WAIT_L(0); PG8_BAR; PG8_MMA(1, 0, At, B0); PG8_MMA(1, 1, At, B1); PG8_BAR; PG8_SCHED;
            } else {
            PG8_LDB(B0, 0, 0); PG8_SCHED; PG8_LDA(At, 0, 0); PG8_STAGE(PG8_SA(1, 1), a1 + hstep, voffA);
            PG8_WAIT_L(8); PG8_BAR; PG8_WAIT_L(0); PG8_MMA(0, 0, At, B0); PG8_BAR; PG8_SCHED;
            PG8_LDB(B1, 0, 1); PG8_STAGE(PG8_SB(0, 0), b2, voffB);
            PG8_BAR; PG8_WAIT_L(0); PG8_MMA(0, 1, At, B1); PG8_BAR;
            PG8_LDA(At, 0, 1); PG8_STAGE(PG8_SA(0, 0), a2, voffA);
            PG8_BAR; PG8_WAIT_L(0); PG8_MMA(1, 0, At, B0); PG8_BAR; PG8_SCHED;
            PG8_STAGE(PG8_SB(0, 1), b2 + hstep, voffB);
            PG8_WAIT_V(6); PG8_BAR; PG8_MMA(1, 1, At, B1); PG8_BAR;
            PG8_LDB(B0, 1, 0); PG8_SCHED; PG8_LDA(At, 1, 0); PG8_STAGE(PG8_SA(0, 1), a2 + hstep, voffA);
            PG8_WAIT_L(8); PG8_BAR; PG8_WAIT_L(0); PG8_MMA(0, 0, At, B0); PG8_BAR; PG8_SCHED;
            PG8_LDB(B1, 1, 1); PG8_STAGE(PG8_SB(1, 0), b3, voffB);
            PG8_BAR; PG8_WAIT_L(0); PG8_MMA(0, 1, At, B1); PG8_BAR;
            PG8_LDA(At, 1, 1); PG8_STAGE(PG8_SA(1, 0), a3, voffA);
            PG8_BAR; PG8_WAIT_L(0); PG8_MMA(1, 0, At, B0); PG8_BAR; PG8_SCHED;
            PG8_STAGE(PG8_SB(1, 1), b3 + hstep, voffB);
            PG8_WAIT_V(6); PG8_BAR; PG8_MMA(1, 1, At, B1); PG8_BAR;
            }
        }
        if constexpr (ALIGN_EPI) { if (wr == 0) PG8_BAR; }
        if constexpr (!Epi::AFTER_DRAIN) { E(acc, cur, wr, wc, fr, fq); S.done(cur); }
        if (!has_next) break;
#pragma unroll
        for (int a = 0; a < 2; ++a)
#pragma unroll
            for (int b = 0; b < 2; ++b)
#pragma unroll
                for (int m = 0; m < 4; ++m)
#pragma unroll
                    for (int n = 0; n < 2; ++n) acc[a][b][m][n] = (f32x4){0.f, 0.f, 0.f, 0.f};
        cur = nxt; cA = nA; cB = nB; ++ui;
        if constexpr (ALIGN_EPI) { if (wr == 1) PG8_BAR; }
    }
    PG8_WAIT_V(0);
    if constexpr (!ALIGN_EPI) { if (wr == 0) PG8_BAR; }
    PG8_BAR;
    if constexpr (Epi::AFTER_DRAIN) { E.fused(acc, cur, wr, wc, fr, fq, lds, wid, lane); S.done(cur); }
#undef PG8_SA
#undef PG8_SB
#undef PG8_STAGE
#undef PG8_LDA
#undef PG8_LDB
#undef PG8_MMA
#undef PG8_WAIT_V
#undef PG8_WAIT_L
#undef PG8_BAR
#undef PG8_SCHED
}
}
namespace att {
using bf16 = __hip_bfloat16;
constexpr int   D = 128, NW = 8, QBLK = 32, KVBLK = 64;
constexpr float SCALE = 0.088388347648318440f;
constexpr float THR = 8.f;
constexpr int SDEPTH = 2;
constexpr int LDQ = 2048, LDK = 512, LDO = 2048;
constexpr size_t SHM_V = KVBLK * D * 2, SHM_K = KVBLK * D * 2, SHM_ATTN = 3 * SHM_V + 3 * SHM_K + NW * 64 * 4;
using bf16x8 = __attribute__((ext_vector_type(8))) short;
using s16x4  = __attribute__((ext_vector_type(4))) short;
using f32x16 = __attribute__((ext_vector_type(16))) float;
using f32x8  = __attribute__((ext_vector_type(8))) float;
using u32x4  = __attribute__((ext_vector_type(4))) unsigned;
using f32x4_t = __attribute__((ext_vector_type(4))) float;
#define KSWZ(row, colB) ((row) * 256 + ((colB) ^ (((row) & 7) << 4)))
#define SBAR() __builtin_amdgcn_sched_barrier(0)
__device__ __forceinline__ int crow(int r, int hi) { return (r & 3) + 8 * (r >> 2) + 4 * hi; }
__device__ __forceinline__ unsigned cvtpk(float lo, float hi) {
  unsigned r; asm volatile("v_cvt_pk_bf16_f32 %0, %1, %2" : "=v"(r) : "v"(lo), "v"(hi)); return r;
}
template <typename TIn> struct Stage;
template <> struct Stage<bf16>  { using T = bf16x8;
  __device__ static __forceinline__ T ld8(const bf16* p) { return *reinterpret_cast<const bf16x8*>(p); }
  __device__ static __forceinline__ bf16x8 tobf(T x) { return x; } };
template <> struct Stage<float> { using T = f32x8;
  __device__ static __forceinline__ T ld8(const float* p) { return *reinterpret_cast<const f32x8*>(p); }
  __device__ static __forceinline__ bf16x8 tobf(T x) {
    u32x4 w = {cvtpk(x[0], x[1]), cvtpk(x[2], x[3]), cvtpk(x[4], x[5]), cvtpk(x[6], x[7])}; return *reinterpret_cast<bf16x8*>(&w); } };

__device__ __forceinline__ void partialSM(f32x16& p0, f32x16& p1, float& m_reg, float& mn, float& alpha) {
  constexpr float C = SCALE * 1.4426950408889634f;
  float pmax = p0[0]; for (int r = 1; r < 16; ++r) pmax = fmaxf(pmax, p0[r]); for (int r = 0; r < 16; ++r) pmax = fmaxf(pmax, p1[r]);
  { auto rr = __builtin_amdgcn_permlane32_swap(__float_as_uint(pmax), __float_as_uint(pmax), false, false);
    pmax = fmaxf(__uint_as_float(rr[0]), __uint_as_float(rr[1])); }
  if (__builtin_expect(__all(pmax - m_reg <= THR / SCALE), 1)) { mn = m_reg; alpha = 1.f; }
  else { mn = fmaxf(m_reg, pmax); alpha = __builtin_amdgcn_exp2f((m_reg - mn) * C); m_reg = mn; }
  float mnC = -mn * C;
  for (int r = 0; r < 16; ++r) p0[r] = fmaf(p0[r], C, mnC); for (int r = 0; r < 16; ++r) p1[r] = fmaf(p1[r], C, mnC);
  for (int r = 0; r < 16; ++r) p0[r] = __builtin_amdgcn_exp2f(p0[r]);
}
__device__ __forceinline__ void finishSM(f32x16& p0, f32x16& p1, float alpha, float& l_reg, bf16x8& pa0, bf16x8& pa1, bf16x8& pa2, bf16x8& pa3) {
  for (int r = 0; r < 16; ++r) p1[r] = __builtin_amdgcn_exp2f(p1[r]);
  float ps = 0; for (int r = 0; r < 16; ++r) ps += p0[r]; for (int r = 0; r < 16; ++r) ps += p1[r];
  { auto rr = __builtin_amdgcn_permlane32_swap(__float_as_uint(ps), __float_as_uint(ps), false, false);
    ps = __uint_as_float(rr[0]) + __uint_as_float(rr[1]); }
  l_reg = l_reg * alpha + ps;
#define PK4(P, BASE, OUT) do { unsigned a0 = cvtpk(P[BASE + 0], P[BASE + 1]), a1 = cvtpk(P[BASE + 2], P[BASE + 3]);   \
    unsigned b0 = cvtpk(P[BASE + 4], P[BASE + 5]), b1 = cvtpk(P[BASE + 6], P[BASE + 7]);                              \
    auto r0 = __builtin_amdgcn_permlane32_swap(a0, b0, false, false); auto r1 = __builtin_amdgcn_permlane32_swap(a1, b1, false, false); \
    u32x4 w = {r0[0], r1[0], r0[1], r1[1]}; OUT = *reinterpret_cast<bf16x8*>(&w); } while (0)
  PK4(p0, 0, pa0); PK4(p0, 8, pa1); PK4(p1, 0, pa2); PK4(p1, 8, pa3);
#undef PK4
}
__device__ __forceinline__ void qkt(f32x16& p0, f32x16& p1, const bf16* Ks, const bf16x8* qr, int r32, int hi) {
  p0 = f32x16{}; p1 = f32x16{};
  for (int d0 = 0; d0 < 8; ++d0) { int cb = (d0 * 16 + hi * 8) * 2;
    bf16x8 b0 = *reinterpret_cast<const bf16x8*>((const char*)Ks + KSWZ(r32, cb));
    bf16x8 b1 = *reinterpret_cast<const bf16x8*>((const char*)Ks + KSWZ(32 + r32, cb));
    p0 = __builtin_amdgcn_mfma_f32_32x32x16_bf16(b0, qr[d0], p0, 0, 0, 0);
    p1 = __builtin_amdgcn_mfma_f32_32x32x16_bf16(b1, qr[d0], p1, 0, 0, 0); }
}
__device__ __forceinline__ int v_st(int k, int c) { const int kk = (k & ~0xC) | ((k & 4) << 1) | ((k & 8) >> 1); return ((kk >> 3) * 4 + (c >> 5)) * 512 + ((kk & 7) * 32 + (c & 31)) * 2; }
__device__ __forceinline__ int v_rd_base(int lane) { return ((lane & 3) << 3) | (((lane >> 2) & 3) << 6) | (((lane >> 4) & 1) << 5) | (((lane >> 5) & 1) << 8); }
constexpr int v_rd_off(int d0, int ks, int half) { return d0 * 512 + ks * 4096 + half * 2048; }
template <int OFF> __device__ __forceinline__ s16x4 tr_read(int vb) {
  s16x4 r; asm volatile("ds_read_b64_tr_b16 %0, %1 offset:%2" : "=&v"(r) : "v"(vb), "i"(OFF) : "memory"); return r;
}
template <int D0> __device__ __forceinline__ void pv_one(f32x16& od, int vb, bf16x8 pa0, bf16x8 pa1, bf16x8 pa2, bf16x8 pa3) {
  const s16x4 l0 = tr_read<v_rd_off(D0, 0, 0)>(vb), h0 = tr_read<v_rd_off(D0, 0, 1)>(vb), l1 = tr_read<v_rd_off(D0, 1, 0)>(vb), h1 = tr_read<v_rd_off(D0, 1, 1)>(vb);
  const s16x4 l2 = tr_read<v_rd_off(D0, 2, 0)>(vb), h2 = tr_read<v_rd_off(D0, 2, 1)>(vb), l3 = tr_read<v_rd_off(D0, 3, 0)>(vb), h3 = tr_read<v_rd_off(D0, 3, 1)>(vb);
  asm volatile("s_waitcnt lgkmcnt(0)" ::: "memory"); SBAR();
#define PK(L, H) (bf16x8){L[0], L[1], L[2], L[3], H[0], H[1], H[2], H[3]}
  od = __builtin_amdgcn_mfma_f32_32x32x16_bf16(pa0, PK(l0, h0), od, 0, 0, 0);
  od = __builtin_amdgcn_mfma_f32_32x32x16_bf16(pa1, PK(l1, h1), od, 0, 0, 0);
  od = __builtin_amdgcn_mfma_f32_32x32x16_bf16(pa2, PK(l2, h2), od, 0, 0, 0);
  od = __builtin_amdgcn_mfma_f32_32x32x16_bf16(pa3, PK(l3, h3), od, 0, 0, 0);
#undef PK
}
__device__ __forceinline__ void pv_d0(f32x16* o, int vb, bf16x8 pa0, bf16x8 pa1, bf16x8 pa2, bf16x8 pa3) {
  pv_one<0>(o[0], vb, pa0, pa1, pa2, pa3); pv_one<1>(o[1], vb, pa0, pa1, pa2, pa3); pv_one<2>(o[2], vb, pa0, pa1, pa2, pa3); pv_one<3>(o[3], vb, pa0, pa1, pa2, pa3);
}

template <typename TQ>
__device__ __forceinline__ void attn_dense_body(const TQ* __restrict__ Qb, const bf16* __restrict__ Kh, const bf16* __restrict__ Vh,
                                                const unsigned short* __restrict__ GAb, const float* __restrict__ watt, unsigned short* __restrict__ Mb, float* __restrict__ ssq, int seq, char* lds) {
  using St = Stage<bf16>; using SQ = Stage<TQ>;
  const int tid = threadIdx.x, wid = tid >> 6, lane = tid & 63, r32 = lane & 31, hi = lane >> 5;
  bf16* V_lds = (bf16*)lds; bf16* K_lds = (bf16*)(lds + 3 * SHM_V);
  float* ws = (float*)(lds + 3 * SHM_V + 3 * SHM_K) + wid * 64; float* li_l = ws; float* al_l = ws + 32;
  float m_reg = -1e30f, l_reg = 0; f32x16 o[4] = {}; bf16x8 qr[8];
  const TQ* Qw = Qb + (long)(wid * QBLK + r32) * LDQ + hi * 8;
#pragma unroll
  for (int d0 = 0; d0 < 8; ++d0) qr[d0] = SQ::tobf(SQ::ld8(Qw + d0 * 16));
  const int sr = tid >> 4, sc = (tid & 15) * 8, vst0 = v_st(sr, sc), vst1 = v_st(32 + sr, sc);
  const int vb0 = (int)(uintptr_t)V_lds + v_rd_base(lane);
  struct { typename St::T vs0, vs1, ks0, ks1; } sr_[SDEPTH];
#define SLOAD(i, k0) do { sr_[i].vs0 = St::ld8(&Vh[(long)((k0) + sr) * LDK + sc]); sr_[i].vs1 = St::ld8(&Vh[(long)((k0) + 32 + sr) * LDK + sc]); \
    sr_[i].ks0 = St::ld8(&Kh[(long)((k0) + sr) * LDK + sc]); sr_[i].ks1 = St::ld8(&Kh[(long)((k0) + 32 + sr) * LDK + sc]); } while (0)
#define SWRITE(b, i) do { *(bf16x8*)((char*)V_lds + (b) * SHM_V + vst0) = St::tobf(sr_[i].vs0);          \
    *(bf16x8*)((char*)V_lds + (b) * SHM_V + vst1) = St::tobf(sr_[i].vs1); int kc = sc * 2;               \
    *(bf16x8*)((char*)K_lds + (b) * SHM_K + KSWZ(sr, kc)) = St::tobf(sr_[i].ks0);                       \
    *(bf16x8*)((char*)K_lds + (b) * SHM_K + KSWZ(32 + sr, kc)) = St::tobf(sr_[i].ks1); } while (0)
#define SWAIT() do { if constexpr (SDEPTH == 2) asm volatile("s_waitcnt vmcnt(4)" ::: "memory"); else asm volatile("s_waitcnt vmcnt(0)" ::: "memory"); } while (0)
#define RESC(a) do { if (__any((a) < 1.f)) { if (hi == 0) al_l[r32] = (a); asm volatile("s_waitcnt lgkmcnt(0)" ::: "memory"); \
    for (int d = 0; d < 4; ++d) for (int r = 0; r < 16; ++r) o[d][r] *= al_l[crow(r, hi)]; } } while (0)
  f32x16 pA0, pA1, pB0, pB1; float mnA, mnB, alA, alB; bf16x8 pa0, pa1, pa2, pa3; const int NT = seq / KVBLK;
  constexpr int SE = 0, SO = SDEPTH - 1;
  SLOAD(SE, 0); asm volatile("s_waitcnt vmcnt(0)" ::: "memory"); SWRITE(0, SE); __syncthreads();
  qkt(pA0, pA1, K_lds, qr, r32, hi); partialSM(pA0, pA1, m_reg, mnA, alA);
  SLOAD(SO, KVBLK); if constexpr (SDEPTH == 2) { if (2 < NT) SLOAD(SE, 2 * KVBLK); }
  SWAIT(); SWRITE(1, SO); __syncthreads();
  int bp = 0, bq = 1, bw = 2;
#define ROT3() do { const int t_ = bp; bp = bq; bq = bw; bw = t_; } while (0)
  for (int j = 1; j + 1 < NT; j += 2) {
    SBAR(); qkt(pB0, pB1, (bf16*)((char*)K_lds + bq * (int)SHM_K), qr, r32, hi);
    finishSM(pA0, pA1, alA, l_reg, pa0, pa1, pa2, pa3); SBAR();
    SLOAD(SO, (j + SDEPTH) * KVBLK); SBAR();
    pv_d0(o, vb0 + bp * (int)SHM_V, pa0, pa1, pa2, pa3); partialSM(pB0, pB1, m_reg, mnB, alB);
    SWAIT(); SWRITE(bw, SE);
    RESC(alB); __syncthreads(); ROT3();
    SBAR(); qkt(pA0, pA1, (bf16*)((char*)K_lds + bq * (int)SHM_K), qr, r32, hi);
    finishSM(pB0, pB1, alB, l_reg, pa0, pa1, pa2, pa3); SBAR();
    if (SDEPTH == 1 || j + 3 < NT) SLOAD(SE, (j + 1 + SDEPTH) * KVBLK); SBAR();
    pv_d0(o, vb0 + bp * (int)SHM_V, pa0, pa1, pa2, pa3); partialSM(pA0, pA1, m_reg, mnA, alA);
    SWAIT(); SWRITE(bw, SO);
    RESC(alA); __syncthreads(); ROT3();
  }
  SBAR(); qkt(pB0, pB1, (bf16*)((char*)K_lds + bq * (int)SHM_K), qr, r32, hi);
  finishSM(pA0, pA1, alA, l_reg, pa0, pa1, pa2, pa3); SBAR();
  pv_d0(o, vb0 + bp * (int)SHM_V, pa0, pa1, pa2, pa3); partialSM(pB0, pB1, m_reg, mnB, alB);
  __syncthreads(); RESC(alB);
  finishSM(pB0, pB1, alB, l_reg, pa0, pa1, pa2, pa3); SBAR();
  pv_d0(o, vb0 + bq * (int)SHM_V, pa0, pa1, pa2, pa3);
#undef ROT3
  if (hi == 0) li_l[r32] = l_reg; asm volatile("s_waitcnt lgkmcnt(0)" ::: "memory");
  float rli[16];
#pragma unroll
  for (int r = 0; r < 16; ++r) rli[r] = __builtin_amdgcn_rcpf(li_l[crow(r, hi)]);
  int lz_; asm volatile("v_mov_b32 %0, 0" : "=v"(lz_));
  const int lane_e = lane + lz_, r32e = lane_e & 31, hie = lane_e >> 5;
  __syncthreads();
  char* stg = lds + wid * 8192;
  float ss[16];
#pragma unroll
  for (int r = 0; r < 16; ++r) { float s = 0.f;
#pragma unroll
    for (int d0 = 0; d0 < 4; ++d0) { const float v = o[d0][r] * rli[r]; s += v * v;
      unsigned u = __builtin_bit_cast(unsigned, v); u = (u + 0x7fffu + ((u >> 16) & 1u)) >> 16;
      *(unsigned short*)(stg + crow(r, hie) * 256 + (d0 * 32 + r32e) * 2) = (unsigned short)u; }
    ss[r] = s; }
#pragma unroll
  for (int r = 0; r < 16; ++r) { float s = ss[r]; s += __shfl_xor(s, 1); s += __shfl_xor(s, 2); s += __shfl_xor(s, 4); s += __shfl_xor(s, 8); s += __shfl_xor(s, 16); ss[r] = s; }
  if (r32e == 0) {
#pragma unroll
    for (int r = 0; r < 16; ++r) ssq[(long)(wid * QBLK + crow(r, hie)) * 16] = ss[r]; }
  {
    asm volatile("s_waitcnt lgkmcnt(0)" ::: "memory");
    const int chunk = lane_e & 15, rsub = lane_e >> 4;
    const f32x4_t w0 = *(const f32x4_t*)(watt + chunk * 8), w1 = *(const f32x4_t*)(watt + chunk * 8 + 4);
#pragma unroll
    for (int p = 0; p < 8; ++p) { const int row = p * 4 + rsub; const long grow = wid * QBLK + row;
      const u32x4 ov = *(const u32x4*)(stg + row * 256 + chunk * 16);
      const u32x4 gv = *(const u32x4*)(GAb + grow * 2048 + chunk * 8);
      u32x4 out;
#define AT_LO(x) __builtin_bit_cast(float, (x) << 16)
#define AT_HI(x) __builtin_bit_cast(float, (x) & 0xffff0000u)
      out[0] = cvtpk(AT_LO(ov[0]) * w0[0] * AT_LO(gv[0]), AT_HI(ov[0]) * w0[1] * AT_HI(gv[0]));
      out[1] = cvtpk(AT_LO(ov[1]) * w0[2] * AT_LO(gv[1]), AT_HI(ov[1]) * w0[3] * AT_HI(gv[1]));
      out[2] = cvtpk(AT_LO(ov[2]) * w1[0] * AT_LO(gv[2]), AT_HI(ov[2]) * w1[1] * AT_HI(gv[2]));
      out[3] = cvtpk(AT_LO(ov[3]) * w1[2] * AT_LO(gv[3]), AT_HI(ov[3]) * w1[3] * AT_HI(gv[3]));
#undef AT_LO
#undef AT_HI
      *(u32x4*)(Mb + grow * 4096 + chunk * 8) = out; } }
#undef SLOAD
#undef SWRITE
#undef SWAIT
#undef RESC
}
}

#ifndef MK_ONE_LAUNCH
#define MK_ONE_LAUNCH 1
#endif
namespace mk {
#define LAS __attribute__((address_space(3)))
typedef unsigned short bf16;
typedef float f32x4 __attribute__((ext_vector_type(4)));
typedef unsigned u32x4 __attribute__((ext_vector_type(4)));
typedef unsigned u32x2 __attribute__((ext_vector_type(2)));
constexpr int D = 4096, NB = 4, S = 2048, C = 256, HD = 128;
constexpr int DATT = 2048, NQH = 16, NKVH = 4, DKV = 512, DLRU = 2048, NBLK = 16, BD = 128;
constexpr int DIN = 9216, DMIX = 4096, DMOD = 3 * D;
constexpr int MX = NB * S, MC = NB * C, MT = MX + MC;
constexpr int SKV = S + C;
constexpr int COL_Q = 0, COL_K = 2048, COL_V = 2560, COL_GA = 3072, COL_XL = 5120, COL_GL = 7168;
constexpr float EPS = 1e-6f;
constexpr int NWAVES = 8, NTHREADS = 512;
constexpr int MISC_OFF = 151552, XS_OFF = MISC_OFF + 1024, LDS_BYTES = XS_OFF + 8192;
constexpr size_t MiB = 1u << 20;
constexpr size_t WS_CTL = 0, WS_MOD = 1 * MiB, WS_ROPE = 1 * MiB + 512 * 1024;
constexpr size_t WS_WIN = 2 * MiB, WS_WOUT = 74 * MiB, WS_H = 106 * MiB, WS_P = 178 * MiB, WS_Q = 340 * MiB, WS_K = 372 * MiB, WS_V = 381 * MiB;
constexpr size_t WS_ATT = 390 * MiB, WS_LF = 454 * MiB, WS_LB = 518 * MiB, WS_END = 582 * MiB, WS_MIX = WS_H;
constexpr size_t WS_SSQA = 390 * MiB, WS_SSQL = 391 * MiB;
constexpr int CW_LRU = 8192, CW_LRUF = 12288;
constexpr size_t WS_RSA_UNUSED = 392 * MiB;
constexpr size_t WS_GA = 178 * MiB, WS_GL = 210 * MiB, WS_XL = 242 * MiB;

struct Args { const float* in[20]; float* out; unsigned char* ws; int ph_lo, ph_hi; };
enum { I_X = 0, I_C, I_CTX, I_CCTX, I_WADA, I_BADA, I_NORMW, I_WIN, I_QNW, I_KNW, I_CONVW, I_CONVB, I_WA, I_BA, I_WX, I_BX, I_LAM, I_ONA, I_ONL, I_WOUT };

__device__ __forceinline__ unsigned f2bf(float f) { unsigned u = __builtin_bit_cast(unsigned, f); return (u + 0x7fffu + ((u >> 16) & 1u)) >> 16; }
__device__ __forceinline__ unsigned pk2(float lo, float hi) { return f2bf(lo) | (f2bf(hi) << 16); }
__device__ __forceinline__ float bf2f(unsigned short v) { return __builtin_bit_cast(float, (unsigned)v << 16); }
__device__ __forceinline__ float bflo(unsigned w) { return __builtin_bit_cast(float, w << 16); }
__device__ __forceinline__ float bfhi(unsigned w) { return __builtin_bit_cast(float, w & 0xffff0000u); }
__device__ __forceinline__ float wave_sum(float v) {
#pragma unroll
    for (int o = 1; o < 64; o <<= 1) v += __shfl_xor(v, o);
    return v;
}
__device__ __forceinline__ float sigmoidf_(float x) { return 1.0f / (1.0f + __expf(-x)); }
__device__ __forceinline__ float siluf_(float x) { return x / (1.0f + __expf(-x)); }

__host__ __device__ __forceinline__ int perm_row(int col) {
    if (col >= COL_V) return col;
    const int d = col & 127, a_ = d >> 6, hf = (d >> 5) & 1, fp = d & 31, wc = a_ * 2 + (fp >> 4), fq = (fp >> 2) & 3, e = fp & 3;
    return (col & ~127) + 32 * wc + 8 * fq + 4 * hf + e;
}
__device__ __forceinline__ void mod_item(const Args& a, LAS float* sc, LAS float* red, int item) {
    const int tid = threadIdx.x, cg = tid & 15, rg = tid >> 4;
    const float* W = a.in[I_WADA] + item * 64 + cg * 4;
    float acc[5][4];
#pragma unroll
    for (int r = 0; r < 5; ++r)
#pragma unroll
        for (int j = 0; j < 4; ++j) acc[r][j] = 0.f;
#pragma unroll 8
    for (int k = rg; k < D; k += 32) {
        const f32x4 w = __builtin_nontemporal_load((const f32x4*)(W + (size_t)k * DMOD));
#pragma unroll
        for (int r = 0; r < 5; ++r) { const float s = sc[r * D + k];
            acc[r][0] += s * w[0]; acc[r][1] += s * w[1]; acc[r][2] += s * w[2]; acc[r][3] += s * w[3]; }
    }
#pragma unroll
    for (int r = 0; r < 5; ++r)
#pragma unroll
        for (int j = 0; j < 4; ++j) red[tid * 20 + r * 4 + j] = acc[r][j];
    __syncthreads();
    if (tid < 320) {
        const int r = tid >> 6, c = tid & 63, cgc = c >> 2, j = c & 3;
        float s = 0.f;
        for (int g = 0; g < 32; ++g) s += red[(g * 16 + cgc) * 20 + r * 4 + j];
        float* mod = (float*)(a.ws + WS_MOD);
        mod[r * DMOD + item * 64 + c] = s + a.in[I_BADA][item * 64 + c];
    }
    __syncthreads();
}
template <bool PERMQK, bool PROD = false> __device__ __forceinline__ void transpose_item(const float* W, int K, int N, bf16* WT, LAS float* scr, int item, int lane) {
    const int nblk = N / 32, kb = item / nblk, nb = item % nblk, k0 = 64 * kb, n0 = 32 * nb;
    if constexpr (PROD) {
        f32x4 t[8];
#pragma unroll
        for (int i = 0; i < 8; ++i) t[i] = *(const f32x4*)(W + (size_t)(k0 + 8 * i + (lane >> 3)) * N + n0 + 4 * (lane & 7));
#pragma unroll
        for (int i = 0; i < 8; ++i) { LAS float* d = scr + (8 * i + (lane >> 3)) * 33 + 4 * (lane & 7); d[0] = t[i][0]; d[1] = t[i][1]; d[2] = t[i][2]; d[3] = t[i][3]; }
    } else {
#pragma unroll 8
        for (int i = 0; i < 32; ++i) { const int kk = 2 * i + (lane >> 5); scr[kk * 33 + (lane & 31)] = W[(size_t)(k0 + kk) * N + n0 + (lane & 31)]; }
    }
    asm volatile("s_waitcnt lgkmcnt(0)" ::: "memory");
    const int c = lane & 7;
#pragma unroll
    for (int j = 0; j < 4; ++j) { const int n = (lane >> 3) + 8 * j; const LAS float* s = scr + (8 * c) * 33 + n;
        u32x4 o; o.x = pk2(s[0 * 33], s[1 * 33]); o.y = pk2(s[2 * 33], s[3 * 33]); o.z = pk2(s[4 * 33], s[5 * 33]); o.w = pk2(s[6 * 33], s[7 * 33]);
        const int nrow = PERMQK ? perm_row(n0 + n) : n0 + n;
        bf16* dp = WT + (size_t)nrow * K + k0 + 8 * c;
        if constexpr (PROD) asm volatile("global_store_dwordx4 %0, %1, off sc1\n\ts_nop 1" :: "v"(dp), "v"(o) : "memory");
        else *(u32x4*)dp = o; }
    asm volatile("s_waitcnt lgkmcnt(0)" ::: "memory");
}
constexpr int NPROD = 16;
constexpr int NEARLY = 12;
constexpr int CW_TILE = 16384;
__host__ __device__ __forceinline__ int tile_order(int j) { return (j >> 1) + 18 * (j & 1); }
__host__ __device__ __forceinline__ bool tile_is_early(int T) { const int l = T % 18; return l < NEARLY / 2; }
template <bool PROD> __device__ __forceinline__ void transpose_tile(const Args& a, LAS float* scr, int T, int wi, int nw, int lane) {
    for (int it = wi; it < 512; it += nw) { const int kb = it >> 3, j = it & 7;
        transpose_item<true, PROD>(a.in[I_WIN], D, DIN, (bf16*)(a.ws + WS_WIN), scr, kb * (DIN / 32) + 8 * T + j, lane); }
}
__device__ __forceinline__ void sincos_d(float angf, float& sn, float& cs) {
    const double x = (double)angf, hp = 1.5707963267948966192;
    const double kq = __builtin_rint(x / hp); const double r = x - kq * hp, r2 = r * r;
    double s = r * (1.0 + r2 * (-1.0 / 6 + r2 * (1.0 / 120 + r2 * (-1.0 / 5040 + r2 * (1.0 / 362880 + r2 * (-1.0 / 39916800 + r2 * (1.0 / 6227020800.0)))))));
    double c = 1.0 + r2 * (-0.5 + r2 * (1.0 / 24 + r2 * (-1.0 / 720 + r2 * (1.0 / 40320 + r2 * (-1.0 / 3628800 + r2 * (1.0 / 479001600.0 + r2 * (-1.0 / 87178291200.0)))))));
    const int q = ((int)kq) & 3;
    double so, co;
    if (q == 0) { so = s; co = c; } else if (q == 1) { so = c; co = -s; } else if (q == 2) { so = -s; co = -c; } else { so = -c; co = s; }
    sn = (float)so; cs = (float)co;
}
__device__ __forceinline__ void phase_prep(const Args& a, LAS unsigned char* lds, int bid, int nb) {
    const int tid = threadIdx.x, lane = tid & 63, wave = tid >> 6;
    if (bid == nb - 1) {
        float* ct = (float*)(a.ws + WS_ROPE); float* st = ct + 64 * 32;
        for (int i = tid; i < 64 * 32; i += NTHREADS) { const int pos = i >> 5, f = i & 31;
            const float freq = exp2f(-(float)f * (13.287712379549449f / 32.0f)); const float ang = (float)pos * freq;
            float sn, cs; sincos_d(ang, sn, cs); ct[i] = cs; st[i] = sn; }
    }
    if (bid < DMOD / 64) {
        LAS float* sc = (LAS float*)lds; LAS float* red = (LAS float*)(lds + 5 * D * 4);
        for (int i = tid; i < 5 * D; i += NTHREADS) { const int r = i / D, k = i % D; const float v = r < 4 ? a.in[I_C][r * D + k] : a.in[I_CCTX][k]; sc[i] = siluf_(v); }
        __syncthreads();
        for (int it = bid; it < DMOD / 64; it += nb) mod_item(a, sc, red, it);
    }
    __syncthreads();
    LAS float* scr = (LAS float*)(lds + wave * 16384);
    const int gw = bid * NWAVES + wave, ngw = nb * NWAVES;
    constexpr int I_IN = (D / 64) * (DIN / 32);
    if (nb == 256) {
        constexpr int NMOD = DMOD / 64;
        if (bid >= NMOD) { for (int j = 0; j < NEARLY; ++j) transpose_tile<false>(a, scr, tile_order(j), (bid - NMOD) * NWAVES + wave, (nb - NMOD) * NWAVES, lane); }
    } else { for (int it = gw; it < I_IN; it += ngw) transpose_item<true>(a.in[I_WIN], D, DIN, (bf16*)(a.ws + WS_WIN), scr, it, lane); }
}
__device__ __forceinline__ void producer_phase(const Args& a, LAS unsigned char* lds, int pidx) {
    const int lane = threadIdx.x & 63, wave = threadIdx.x >> 6;
    LAS float* scr = (LAS float*)(lds + wave * 16384);
    unsigned* cnt = (unsigned*)(a.ws + WS_CTL) + CW_TILE;
    for (int j = NEARLY; j < 36; ++j) { const int T = tile_order(j);
        transpose_tile<true>(a, scr, T, pidx * NWAVES + wave, NPROD * NWAVES, lane);
        asm volatile("s_waitcnt vmcnt(0)" ::: "memory");
        if (lane == 0) __hip_atomic_fetch_add(cnt + T * 16, 1u, __ATOMIC_RELAXED, __HIP_MEMORY_SCOPE_AGENT); }
    constexpr int I_OUT = (DMIX / 64) * (D / 32);
    for (int it = pidx * NWAVES + wave; it < I_OUT; it += NPROD * NWAVES) transpose_item<false, true>(a.in[I_WOUT], DMIX, D, (bf16*)(a.ws + WS_WOUT), scr, it, lane);
}
__device__ __forceinline__ void wout_transpose(const Args& a, LAS unsigned char* lds, int idx, int n) {
    const int lane = threadIdx.x & 63, wave = threadIdx.x >> 6;
    LAS float* scr = (LAS float*)(lds + wave * 16384);
    constexpr int I_OUT = (DMIX / 64) * (D / 32);
    for (int it = idx * NWAVES + wave; it < I_OUT; it += n * NWAVES) transpose_item<false>(a.in[I_WOUT], DMIX, D, (bf16*)(a.ws + WS_WOUT), scr, it, lane);
}
constexpr int CW_ROWS = CW_TILE + 16 * 40;
__device__ __forceinline__ void phase_norm(const Args& a, LAS unsigned char* lds, int bid, int nb, bool flow) {
    const int tid = threadIdx.x, lane = tid & 63, wave = tid >> 6;
    const float* mod = (const float*)(a.ws + WS_MOD); bf16* H = (bf16*)(a.ws + WS_H); const float* nw = a.in[I_NORMW];
    unsigned* rcnt = (unsigned*)(a.ws + WS_CTL) + CW_ROWS; int prev_pm = -1;
    const bool even = (nb * NWAVES * 4 == MX) && (nb * (NWAVES / 2) == MC);
    if (even) {
        const int row = MX + bid * (NWAVES / 2) + (wave >> 1), hf = wave & 1;
        const float* src = a.in[I_CTX] + (size_t)(row - MX) * D + hf * (D / 2);
        const float* shift = mod + 4 * DMOD + hf * (D / 2); const float* scale = shift + D; const float* nwh = nw + hf * (D / 2);
        f32x4 v[8]; float s = 0.f;
#pragma unroll
        for (int j = 0; j < 8; ++j) { v[j] = *(const f32x4*)(src + 4 * (lane + 64 * j)); s += (v[j][0] * v[j][0] + v[j][1] * v[j][1]) + (v[j][2] * v[j][2] + v[j][3] * v[j][3]); }
        s = wave_sum(s);
        LAS float* red = (LAS float*)lds;
        if (lane == 0) red[wave] = s;
        __syncthreads();
        s = red[wave] + red[wave ^ 1];
        const float rstd = 1.0f / sqrtf(s * (1.0f / D) + EPS);
#pragma unroll
        for (int j = 0; j < 8; ++j) { const int c = 4 * (lane + 64 * j);
            const f32x4 w = *(const f32x4*)(nwh + c), sc = *(const f32x4*)(scale + c), sh = *(const f32x4*)(shift + c);
            f32x4 h;
#pragma unroll
            for (int e = 0; e < 4; ++e) h[e] = (v[j][e] * rstd * w[e]) * (1.0f + sc[e]) + sh[e];
            u32x2 o; o.x = pk2(h[0], h[1]); o.y = pk2(h[2], h[3]);
            if (flow) asm volatile("global_store_dwordx2 %0, %1, off sc1\n\ts_nop 1" :: "v"(H + (size_t)row * D + hf * (D / 2) + c), "v"(o) : "memory");
            else *(u32x2*)(H + (size_t)row * D + hf * (D / 2) + c) = o; }
        prev_pm = row >> 8;
    }
    for (int row = bid * NWAVES + wave; row < (even ? MX : MT); row += nb * NWAVES) {
        const float* src = row < MX ? a.in[I_X] + (size_t)row * D : a.in[I_CTX] + (size_t)(row - MX) * D;
        const int bsel = row < MX ? row / S : 4;
        const float* shift = mod + bsel * DMOD; const float* scale = shift + D;
        f32x4 v[16]; float s = 0.f;
#pragma unroll
        for (int j = 0; j < 16; ++j) { v[j] = *(const f32x4*)(src + 4 * (lane + 64 * j)); s += (v[j][0] * v[j][0] + v[j][1] * v[j][1]) + (v[j][2] * v[j][2] + v[j][3] * v[j][3]); }
        s = wave_sum(s);
        if (flow && prev_pm >= 0) { asm volatile("s_waitcnt vmcnt(0)" ::: "memory");
            if (lane == 0) __hip_atomic_fetch_add(rcnt + 16 * prev_pm, 1u, __ATOMIC_RELAXED, __HIP_MEMORY_SCOPE_AGENT); }
        const float rstd = 1.0f / sqrtf(s * (1.0f / D) + EPS);
#pragma unroll
        for (int j = 0; j < 16; ++j) { const int c = 4 * (lane + 64 * j);
            const f32x4 w = *(const f32x4*)(nw + c), sc = *(const f32x4*)(scale + c), sh = *(const f32x4*)(shift + c);
            f32x4 h;
#pragma unroll
            for (int e = 0; e < 4; ++e) h[e] = (v[j][e] * rstd * w[e]) * (1.0f + sc[e]) + sh[e];
            u32x2 o; o.x = pk2(h[0], h[1]); o.y = pk2(h[2], h[3]);
            if (flow) asm volatile("global_store_dwordx2 %0, %1, off sc1\n\ts_nop 1" :: "v"(H + (size_t)row * D + c), "v"(o) : "memory");
            else *(u32x2*)(H + (size_t)row * D + c) = o; }
        prev_pm = row >> 8;
    }
    if (flow && prev_pm >= 0) { asm volatile("s_waitcnt vmcnt(0)" ::: "memory");
        if (lane == 0) __hip_atomic_fetch_add(rcnt + 16 * prev_pm, 1u, __ATOMIC_RELAXED, __HIP_MEMORY_SCOPE_AGENT); }
}
__device__ __forceinline__ void phase_qkprep(const Args& a, int bid, int nb) {
    const int tid = threadIdx.x, lane = tid & 63, wave = tid >> 6;
    const bf16* P = (const bf16*)(a.ws + WS_P); bf16* Qb = (bf16*)(a.ws + WS_Q); bf16* Kb = (bf16*)(a.ws + WS_K); bf16* Vb = (bf16*)(a.ws + WS_V);
    const float* ct = (const float*)(a.ws + WS_ROPE); const float* st = ct + 64 * 32;
    const int hsel = lane >> 5, f = lane & 31;
    for (int idx = bid * NWAVES + wave; idx < MT * 20; idx += nb * NWAVES) {
        const int row = idx / 20, hh = idx % 20; const bool isx = row < MX;
        if (hh < NQH && !isx) continue;
        const bf16* src = P + (size_t)row * DIN + (hh < NQH ? COL_Q + hh * HD : COL_K + (hh - NQH) * HD);
        float x1 = bf2f(src[hsel * 64 + f]), x2 = bf2f(src[hsel * 64 + 32 + f]);
        const float ss = wave_sum(x1 * x1 + x2 * x2);
        const float rstd = 1.0f / sqrtf(ss * (1.0f / HD) + EPS);
        const float* w = hh < NQH ? a.in[I_QNW] : a.in[I_KNW];
        x1 = x1 * rstd * w[hsel * 64 + f]; x2 = x2 * rstd * w[hsel * 64 + 32 + f];
        int bb, tok;
        if (isx) { bb = row / S; const int t = row % S; tok = t; const int pos = hsel == 0 ? t / 64 : t % 64;
            const float cs = ct[pos * 32 + f], sn = st[pos * 32 + f];
            const float o1 = x1 * cs - x2 * sn, o2 = x2 * cs + x1 * sn; x1 = o1; x2 = o2; }
        else { bb = (row - MX) / C; tok = S + (row - MX) % C; }
        bf16* dst = hh < NQH ? Qb + (size_t)row * DATT + hh * HD : Kb + ((size_t)bb * SKV + tok) * DKV + (hh - NQH) * HD;
        dst[hsel * 64 + f] = (bf16)f2bf(x1); dst[hsel * 64 + 32 + f] = (bf16)f2bf(x2);
    }
    for (int idx = bid * NTHREADS + tid; idx < MT * 64; idx += nb * NTHREADS) {
        const int row = idx >> 6, c8 = idx & 63; const bool isx = row < MX;
        const int bb = isx ? row / S : (row - MX) / C, tok = isx ? row % S : S + (row - MX) % C;
        *(u32x4*)(Vb + ((size_t)bb * SKV + tok) * DKV + c8 * 8) = *(const u32x4*)(P + (size_t)row * DIN + COL_V + c8 * 8);
    }
}
__device__ __forceinline__ void phase_attn(const Args& a, char* lds, int bid, int nb) {
    const att::bf16* Qb = (const att::bf16*)(a.ws + WS_Q); const att::bf16* Kb = (const att::bf16*)(a.ws + WS_K); const att::bf16* Vb = (const att::bf16*)(a.ws + WS_V);
    const bf16* GAp = (const bf16*)(a.ws + WS_GA); bf16* MIX = (bf16*)(a.ws + WS_MIX); float* SSQA = (float*)(a.ws + WS_SSQA);
    for (int item = bid; item < NB * NQH * (S / 256); item += nb) {
        const int b = item / 128, rem = item % 128, kvh = rem / 32, g = (rem % 32) / 8, qb = rem % 8, h = kvh * 4 + g;
        const size_t row0 = (size_t)b * S + qb * 256;
        const size_t q0 = row0 * DATT + h * HD, k0 = (size_t)b * SKV * DKV + kvh * HD;
        att::attn_dense_body<att::bf16>(Qb + q0, Kb + k0, Vb + k0, GAp + q0, a.in[I_ONA] + h * HD, MIX + row0 * DMIX + h * HD, SSQA + row0 * 16 + h, SKV, lds);
        __syncthreads();
    }
}
template <int NPF> __device__ __forceinline__ void lru_merge_slice(const Args& a, int b, int n, int hc, int tid, int t0, int npass) {
    const bf16* GLp = (const bf16*)(a.ws + WS_GL); const bf16* LF = (const bf16*)(a.ws + WS_LF); const bf16* LB = (const bf16*)(a.ws + WS_LB);
    float* SSQL = (float*)(a.ws + WS_SSQL); bf16* MIX = (bf16*)(a.ws + WS_MIX);
    const int c8 = tid & 7, rsub = tid >> 3, ch0 = n * BD + hc * 64 + c8 * 8;
    const f32x4 w0 = *(const f32x4*)(a.in[I_ONL] + ch0), w1 = *(const f32x4*)(a.in[I_ONL] + ch0 + 4);
    (void)npass;
    for (int p0 = t0 / 64; p0 < t0 / 64 + NPF; p0 += NPF) {
        u32x4 f[NPF], k[NPF], gg[NPF];
#pragma unroll
        for (int j = 0; j < NPF; ++j) { const size_t o = ((size_t)(((b * NBLK + n) * 2 + hc) * S) + (p0 + j) * 64 + rsub) * 64 + c8 * 8; f[j] = *(const u32x4*)(LF + o); k[j] = *(const u32x4*)(LB + o); gg[j] = *(const u32x4*)(GLp + o); }
#pragma unroll
        for (int j = 0; j < NPF; ++j) { const size_t row = (size_t)b * S + (p0 + j) * 64 + rsub;
            float v[8]; float s = 0.f;
#pragma unroll
            for (int e = 0; e < 4; ++e) { v[2 * e] = bflo(f[j][e]) + bflo(k[j][e]); v[2 * e + 1] = bfhi(f[j][e]) + bfhi(k[j][e]); s += v[2 * e] * v[2 * e] + v[2 * e + 1] * v[2 * e + 1]; }
            s += __shfl_xor(s, 1); s += __shfl_xor(s, 2); s += __shfl_xor(s, 4);
            u32x4 oo;
            oo[0] = pk2(v[0] * w0[0] * bflo(gg[j][0]), v[1] * w0[1] * bfhi(gg[j][0])); oo[1] = pk2(v[2] * w0[2] * bflo(gg[j][1]), v[3] * w0[3] * bfhi(gg[j][1]));
            oo[2] = pk2(v[4] * w1[0] * bflo(gg[j][2]), v[5] * w1[1] * bfhi(gg[j][2])); oo[3] = pk2(v[6] * w1[2] * bflo(gg[j][3]), v[7] * w1[3] * bfhi(gg[j][3]));
            *(u32x4*)(MIX + row * DMIX + DATT + ch0) = oo;
            if (c8 == 0) SSQL[row * 32 + n * 2 + hc] = s; } }
}
typedef short bf16x8_t __attribute__((ext_vector_type(8)));
constexpr int LRU_RAW = 0, LRU_UA = 132 * 256, LRU_UF = LRU_UA + 128 * 256, LRU_XCH = LRU_UF + 128 * 256, LRU_OUT = LRU_XCH + 1024, LRU_RAW2 = LRU_OUT + 128 * 128, LRU_LDS = LRU_RAW2 + 132 * 256;
static_assert(LRU_LDS <= MISC_OFF, "LRU scratch runs into the LDS control words");
__device__ __forceinline__ void phase_lru(const Args& a, LAS unsigned char* lds, int bid, int nb) {
    const int tid = threadIdx.x, lane = tid & 63, w = __builtin_amdgcn_readfirstlane(tid >> 6), g = lane >> 4, c16 = lane & 15, cgq = w & 3, th = w >> 2;
    const bf16* XLp = (const bf16*)(a.ws + WS_XL);
    for (int item = bid; item < NB * 2 * NBLK * 2; item += nb) {
        const int b = item >> 6, dir = (item >> 5) & 1, n = (item >> 1) & 15, hc = item & 1;
        bf16x8_t Bwa[4], Bwx[4];
        { const float* wa = a.in[I_WA] + (size_t)(dir * NBLK + n) * BD * BD + hc * 64 + 16 * cgq + c16; const float* wx = a.in[I_WX] + (size_t)(dir * NBLK + n) * BD * BD + hc * 64 + 16 * cgq + c16;
#pragma unroll
          for (int ks = 0; ks < 4; ++ks) { u32x4 pa, px;
#pragma unroll
              for (int jj = 0; jj < 4; ++jj) { const int k0 = 32 * ks + 8 * g + 2 * jj;
                  pa[jj] = pk2(wa[(size_t)k0 * BD], wa[(size_t)(k0 + 1) * BD]); px[jj] = pk2(wx[(size_t)k0 * BD], wx[(size_t)(k0 + 1) * BD]); }
              Bwa[ks] = __builtin_bit_cast(bf16x8_t, pa); Bwx[ks] = __builtin_bit_cast(bf16x8_t, px); } }
        const int chg = n * BD + hc * 64 + 16 * cgq + c16;
        const float ba = a.in[I_BA][dir * DLRU + chg], bx = a.in[I_BX][dir * DLRU + chg];
        const float sp16 = 16.0f * log1pf(expf(-a.in[I_LAM][dir * DLRU + chg]));
        constexpr float L2E = 1.4426950408889634f;
        const float nba = -ba * L2E, nbx = -bx * L2E, cav = -0.5f * L2E * sp16;
        const int chc = n * BD + 2 * lane;
        typedef float f32x2 __attribute__((ext_vector_type(2)));
        f32x2 cwv[4], cbv;
        cbv = (f32x2){a.in[I_CONVB][chc], a.in[I_CONVB][chc + 1]};
#pragma unroll
        for (int jj = 0; jj < 4; ++jj) cwv[jj] = (f32x2){a.in[I_CONVW][jj * DLRU + chc], a.in[I_CONVW][jj * DLRU + chc + 1]};
        const bool own = (lane >> 5) == hc;
        bf16* outp = (bf16*)(a.ws + (dir == 0 ? WS_LF : WS_LB));
        float h_in = 0.f;
        u32x4 R[5];
        const int lrow = tid >> 4, lc = tid & 15;
#define LRU_LOAD(k) do { const bool isc_ = (k) < 2; const int pl0_ = isc_ ? 128 * (k) : 128 * ((k) - 2), len_ = isc_ ? C : S; \
            const int tlo_ = dir == 0 ? pl0_ : len_ - 128 - pl0_; const size_t rb_ = isc_ ? (size_t)MX + (size_t)b * C : (size_t)b * S; \
            _Pragma("unroll") for (int ps = 0; ps < 5; ++ps) { const int r_ = lrow + 32 * ps, t_ = tlo_ - 2 + r_; \
                R[ps] = (u32x4){0u, 0u, 0u, 0u}; \
                if (r_ < 132 && t_ >= 0 && t_ < len_) R[ps] = *(const u32x4*)(XLp + (rb_ + t_) * DLRU + n * BD + 8 * lc); } } while (0)
#define LRU_BAR() do { asm volatile("s_waitcnt lgkmcnt(0)" ::: "memory"); __builtin_amdgcn_s_barrier(); asm volatile("" ::: "memory"); } while (0)
#define LRU_COPYOUT(kk) do { const int tl_ = dir == 0 ? 128 * ((kk) - 2) : S - 128 - 128 * ((kk) - 2); \
            _Pragma("unroll") for (int j_ = 0; j_ < 2; ++j_) { const int p_ = tid + 512 * j_, s_ = p_ >> 3, c8_ = p_ & 7, tt_ = tl_ + (dir == 0 ? s_ : 127 - s_); \
                const u32x4 v_ = *(const LAS u32x4*)(lds + LRU_OUT + s_ * 128 + c8_ * 16); bf16* p_o = outp + ((size_t)(((b * NBLK + n) * 2 + hc) * S) + tt_) * 64 + c8_ * 8; \
                asm volatile("global_store_dwordx4 %0, %1, off sc1\n\ts_nop 1" :: "v"(p_o), "v"(v_) : "memory"); } } while (0)
        const bf16* partp = (const bf16*)(a.ws + (dir == 0 ? WS_LB : WS_LF)) + (size_t)(((b * NBLK + n) * 2 + hc) * S) * 64;
        const bf16* glsp = (const bf16*)(a.ws + WS_GL) + (size_t)(((b * NBLK + n) * 2 + hc) * S) * 64;
#define LRU_MERGE_LOAD(kk) do { const int tl_ = dir == 0 ? 128 * ((kk) - 2) : S - 128 - 128 * ((kk) - 2); \
            _Pragma("unroll") for (int j_ = 0; j_ < 2; ++j_) { const int p_ = tid + 512 * j_, s_ = p_ >> 3, c8_ = p_ & 7, tt_ = tl_ + (dir == 0 ? s_ : 127 - s_); \
                const unsigned ob_ = (unsigned)(tt_ * 128 + c8_ * 16); PT[j_] = *(const u32x4*)((const char*)partp + ob_); GT[j_] = *(const u32x4*)((const char*)glsp + ob_); } } while (0)
#define LRU_MERGE_STORE(kk) do { const int tl_ = dir == 0 ? 128 * ((kk) - 2) : S - 128 - 128 * ((kk) - 2); \
            _Pragma("unroll") for (int j_ = 0; j_ < 2; ++j_) { const int p_ = tid + 512 * j_, s_ = p_ >> 3, c8_ = p_ & 7, tt_ = tl_ + (dir == 0 ? s_ : 127 - s_); \
                const u32x4 ov_ = *(const LAS u32x4*)(lds + LRU_OUT + s_ * 128 + c8_ * 16); const int cm_ = n * BD + hc * 64 + c8_ * 8; \
                const f32x4 w0_ = *(const f32x4*)(a.in[I_ONL] + cm_), w1_ = *(const f32x4*)(a.in[I_ONL] + cm_ + 4); \
                float v_[8]; float ss_ = 0.f; \
                _Pragma("unroll") for (int e_ = 0; e_ < 4; ++e_) { v_[2 * e_] = bflo(ov_[e_]) + bflo(PT[j_][e_]); v_[2 * e_ + 1] = bfhi(ov_[e_]) + bfhi(PT[j_][e_]); ss_ += v_[2 * e_] * v_[2 * e_] + v_[2 * e_ + 1] * v_[2 * e_ + 1]; } \
                ss_ += __shfl_xor(ss_, 1); ss_ += __shfl_xor(ss_, 2); ss_ += __shfl_xor(ss_, 4); \
                u32x4 oo_; \
                oo_[0] = pk2(v_[0] * w0_[0] * bflo(GT[j_][0]), v_[1] * w0_[1] * bfhi(GT[j_][0])); oo_[1] = pk2(v_[2] * w0_[2] * bflo(GT[j_][1]), v_[3] * w0_[3] * bfhi(GT[j_][1])); \
                oo_[2] = pk2(v_[4] * w1_[0] * bflo(GT[j_][2]), v_[5] * w1_[1] * bfhi(GT[j_][2])); oo_[3] = pk2(v_[6] * w1_[2] * bflo(GT[j_][3]), v_[7] * w1_[3] * bfhi(GT[j_][3])); \
                const unsigned row_ = (unsigned)(b * S + tt_); \
                *(u32x4*)((char*)(a.ws + WS_MIX) + (unsigned)((row_ * (unsigned)DMIX + (unsigned)(DATT + cm_)) * 2u)) = oo_; \
                if (c8_ == 0) *(float*)((char*)(a.ws + WS_SSQL) + (unsigned)((row_ * 32u + (unsigned)(n * 2 + hc)) * 4u)) = ss_; } } while (0)
        __syncthreads();
        LRU_LOAD(0);
#define LRU_RAWPUT(kk) do { const int rb_ = ((kk) & 1) ? LRU_RAW2 : LRU_RAW; \
            _Pragma("unroll") for (int ps = 0; ps < 5; ++ps) { const int r_ = lrow + 32 * ps; if (r_ < 132) *(LAS u32x4*)(lds + rb_ + r_ * 256 + lc * 16) = R[ps]; } } while (0)
        LRU_RAWPUT(0); LRU_BAR(); LRU_LOAD(1);
        for (int k = 0; k < 18; ++k) {
            if (k == 10) asm volatile("s_waitcnt vmcnt(0)" ::: "memory");
            const bool isc = k < 2; const int pl0 = isc ? 128 * k : 128 * (k - 2), len = isc ? C : S; const int tlo = dir == 0 ? pl0 : len - 128 - pl0;
            const int rawb = (k & 1) ? LRU_RAW2 : LRU_RAW;
            const bool flag10 = (k == 10 && tid == 0);
            if (k == 12) {
                if (tid == 0) { unsigned* pf = (unsigned*)(a.ws + WS_CTL) + CW_LRUF + (item ^ 32) * 16; unsigned sp = 0;
                    while (__hip_atomic_load(pf, __ATOMIC_RELAXED, __HIP_MEMORY_SCOPE_AGENT) == 0u && ++sp < (1u << 22)) __builtin_amdgcn_s_sleep(2);
                    __builtin_amdgcn_fence(__ATOMIC_ACQUIRE, "agent"); asm volatile("s_waitcnt vmcnt(0)" ::: "memory"); }
                LRU_BAR(); }
            u32x4 PT[2], GT[2];
            if (k >= 12) LRU_MERGE_LOAD(k - 1);
            { f32x2 xr[19];
#pragma unroll
              for (int rr = 0; rr < 19; ++rr) { const unsigned v = *(const LAS unsigned*)(lds + rawb + (16 * w + rr) * 256 + lane * 4); xr[rr] = (f32x2){bflo(v), bfhi(v)}; }
#pragma unroll
              for (int e = 0; e < 16; ++e) { const int i = 16 * w + e, s = dir == 0 ? i : 127 - i, key = (((s >> 4) & 3) << 2) | (s & 3);
                  const f32x2 u = cbv + cwv[0] * xr[e] + cwv[1] * xr[e + 1] + cwv[2] * xr[e + 2] + cwv[3] * xr[e + 3];
                  *(LAS unsigned*)(lds + LRU_UA + s * 256 + ((((2 * lane) >> 3) ^ key) << 4) + ((2 * lane) & 7) * 2) = pg8::cvt_pk_bf16(u[0], u[1]);
                  if (own) *(LAS f32x2*)(lds + LRU_UF + s * 256 + (2 * (lane & 31)) * 4) = u; } }
            LRU_BAR();
            if (flag10) __hip_atomic_store((unsigned*)(a.ws + WS_CTL) + CW_LRUF + item * 16, 1u, __ATOMIC_RELAXED, __HIP_MEMORY_SCOPE_AGENT);
            if (k >= 3 && k < 12) LRU_COPYOUT(k - 1);
            f32x4 ar[4], ai[4];
#pragma unroll
            for (int m = 0; m < 4; ++m) { ar[m] = (f32x4){0.f, 0.f, 0.f, 0.f}; ai[m] = (f32x4){0.f, 0.f, 0.f, 0.f}; }
#pragma unroll
            for (int ks = 0; ks < 4; ++ks)
#pragma unroll
                for (int m = 0; m < 4; ++m) { const int s = 64 * th + 16 * (c16 >> 2) + 4 * m + (c16 & 3);
                    const bf16x8_t af = *(const LAS bf16x8_t*)(lds + LRU_UA + s * 256 + (((4 * ks + g) ^ c16) << 4));
                    ar[m] = __builtin_amdgcn_mfma_f32_16x16x32_bf16(af, Bwa[ks], ar[m], 0, 0, 0);
                    ai[m] = __builtin_amdgcn_mfma_f32_16x16x32_bf16(af, Bwx[ks], ai[m], 0, 0, 0); }
            float Ac = 1.f, Hl = 0.f; f32x2 AcT[4][2], HlT[4][2];
#pragma unroll
            for (int m = 0; m < 4; ++m)
#pragma unroll
                for (int hp = 0; hp < 2; ++hp) { const int s = 64 * th + 16 * g + 4 * m + 2 * hp;
                    const f32x2 uu = (f32x2){*(const LAS float*)(lds + LRU_UF + s * 256 + (16 * cgq + c16) * 4), *(const LAS float*)(lds + LRU_UF + (s + 1) * 256 + (16 * cgq + c16) * 4)};
                    const f32x2 x1 = (f32x2){ar[m][2 * hp], ar[m][2 * hp + 1]} * (-L2E) + nba, x2 = (f32x2){ai[m][2 * hp], ai[m][2 * hp + 1]} * (-L2E) + nbx;
                    const f32x2 d1 = (f32x2){__builtin_amdgcn_exp2f(x1[0]), __builtin_amdgcn_exp2f(x1[1])} + 1.0f, d2 = (f32x2){__builtin_amdgcn_exp2f(x2[0]), __builtin_amdgcn_exp2f(x2[1])} + 1.0f;
                    const f32x2 rg = (f32x2){__builtin_amdgcn_rcpf(d1[0]), __builtin_amdgcn_rcpf(d1[1])}, ig = (f32x2){__builtin_amdgcn_rcpf(d2[0]), __builtin_amdgcn_rcpf(d2[1])};
                    const f32x2 ea = rg * cav; const f32x2 av = (f32x2){__builtin_amdgcn_exp2f(ea[0]), __builtin_amdgcn_exp2f(ea[1])};
                    const f32x2 t = rg * sp16, qf = t * (1.0f + t * (-0.5f + t * ((1.0f / 6) + t * ((-1.0f / 24) + t * (1.0f / 120))))), qg = 1.0f - av * av;
                    const f32x2 q1 = (f32x2){t[0] < 0.25f ? qf[0] : qg[0], t[1] < 0.25f ? qf[1] : qg[1]};
                    const f32x2 bv = (f32x2){__builtin_amdgcn_sqrtf(q1[0]), __builtin_amdgcn_sqrtf(q1[1])} * (ig * uu);
                    f32x2 Ao, Ho;
                    Ac *= av[0]; Hl = av[0] * Hl + bv[0]; Ao[0] = Ac; Ho[0] = Hl;
                    Ac *= av[1]; Hl = av[1] * Hl + bv[1]; Ao[1] = Ac; Ho[1] = Hl;
                    AcT[m][hp] = Ao; HlT[m][hp] = Ho; if (hp == 1) __builtin_amdgcn_sched_barrier(0); }
            float As = Ac, Hs = Hl;
            { float Ap = __shfl_up(As, 16), Hp = __shfl_up(Hs, 16); if (g >= 1) { Hs = As * Hp + Hs; As = As * Ap; } }
            { float Ap = __shfl_up(As, 32), Hp = __shfl_up(Hs, 32); if (g >= 2) { Hs = As * Hp + Hs; As = As * Ap; } }
            float Ae = __shfl_up(As, 16), He = __shfl_up(Hs, 16); if (g == 0) { Ae = 1.f; He = 0.f; }
            const float A3 = __shfl(As, 48 + c16), H3 = __shfl(Hs, 48 + c16);
            { typedef float f32x2 __attribute__((ext_vector_type(2)));
              if (g == 0) *(LAS f32x2*)(lds + LRU_XCH + ((th * 4 + cgq) * 16 + c16) * 8) = (f32x2){A3, H3};
              if (k >= 12) LRU_MERGE_STORE(k - 1);
              if (k + 1 < 18) LRU_RAWPUT(k + 1);
              LRU_BAR();
              if (k + 2 < 18) LRU_LOAD(k + 2);
              const f32x2 pp = *(const LAS f32x2*)(lds + LRU_XCH + (((th ^ 1) * 4 + cgq) * 16 + c16) * 8);
              float cw_;
              if (th == 0) { cw_ = h_in; h_in = pp[0] * (A3 * h_in + H3) + pp[1]; }
              else         { cw_ = pp[0] * h_in + pp[1]; h_in = A3 * cw_ + H3; }
              const float cin = Ae * cw_ + He;
              if (!isc) {
#pragma unroll
                  for (int m = 0; m < 4; ++m)
#pragma unroll
                      for (int hp = 0; hp < 2; ++hp) { const int s = 64 * th + 16 * g + 4 * m + 2 * hp; const f32x2 hv = HlT[m][hp] + AcT[m][hp] * cin;
                          const unsigned pk = pg8::cvt_pk_bf16(hv[0], hv[1]);
                          *(LAS bf16*)(lds + LRU_OUT + s * 128 + (16 * cgq + c16) * 2) = (bf16)(pk & 0xffffu); *(LAS bf16*)(lds + LRU_OUT + (s + 1) * 128 + (16 * cgq + c16) * 2) = (bf16)(pk >> 16); }
              } }
        }
        __syncthreads(); { u32x4 PT[2], GT[2]; LRU_MERGE_LOAD(17); LRU_MERGE_STORE(17); }
        asm volatile("s_waitcnt vmcnt(0)" ::: "memory");
        __syncthreads();
        { LAS unsigned* flag = (LAS unsigned*)(lds + LRU_XCH);
          if (tid == 0) {
              const unsigned old_ = __hip_atomic_fetch_add((unsigned*)(a.ws + WS_CTL) + CW_LRU + ((b * NBLK + n) * 2 + hc) * 16, 1u, __ATOMIC_RELAXED, __HIP_MEMORY_SCOPE_AGENT);
              if (old_ == 1u) { __builtin_amdgcn_fence(__ATOMIC_ACQUIRE, "agent"); asm volatile("s_waitcnt vmcnt(0)" ::: "memory"); }
              *flag = old_; }
          __syncthreads();
          if (*flag == 1u) { int tq = tid; asm volatile("" : "+v"(tq)); lru_merge_slice<4>(a, b, n, hc, tq, 7 * 128, 4); } }
#undef LRU_LOAD
#undef LRU_RAWPUT
#undef LRU_COPYOUT
#undef LRU_MERGE_LOAD
#undef LRU_MERGE_STORE
#undef LRU_BAR
    }
}
struct InProjOrder {
    pg8::StaticOrder so; int G, c; const unsigned* ready; int need; bool flow;
    __device__ void init(int G_, int c_, const unsigned* ready_, int need_, bool flow_) { so.init(MX, DIN, G_, c_); G = G_; c = c_; ready = ready_; need = need_; flow = flow_; }
    __device__ bool next(int i, pg8::Unit& u) const {
        const int L = i * G + c;
        if (L < 1152) return so.next(i, u);
        if (L >= 1200) return false;
        const int idx = L - 1152, j = idx >> 2; u.pm = 32 + (idx & 3); u.pn = j < 4 ? 8 + j : 16 + j; u.ui = i; return true;
    }
    __device__ __forceinline__ void a_ready(const pg8::Unit& u) const {
        if (need == 0 && !flow) return;
        const unsigned wantT = (need != 0 && !tile_is_early(u.pn)) ? (unsigned)need : 0u, wantR = flow ? (u.pm >= MX / 256 ? 512u : 256u) : 0u;
        if (threadIdx.x < 64 && (wantT | wantR) != 0u) {
            const int lane = threadIdx.x;
            const unsigned* p = ready + (lane == 0 ? 16 * u.pn : 16 * (40 + u.pm));
            const unsigned want = lane == 0 ? wantT : (lane == 1 ? wantR : 0u);
            unsigned polls = 0;
            for (;;) { const unsigned v = lane < 2 ? __hip_atomic_load(p, __ATOMIC_RELAXED, __HIP_MEMORY_SCOPE_AGENT) : 0xffffffffu;
                if (__all(v >= want) || ++polls > (1u << 22)) break; __builtin_amdgcn_s_sleep(2); }
            __builtin_amdgcn_fence(__ATOMIC_ACQUIRE, "agent");
            asm volatile("s_waitcnt vmcnt(0)" ::: "memory");
        }
        asm volatile("" ::: "memory"); __builtin_amdgcn_s_barrier(); asm volatile("" ::: "memory");
    }
    __device__ __forceinline__ void done(const pg8::Unit&) const {}
};
struct EpiInProj {
    static constexpr bool PERM = true, AFTER_DRAIN = false, MIDSCALE = false;
    bf16 *Qb, *Kb, *Vb, *GA, *XL, *GL; const float *qnw, *knw, *ct, *st; LAS float* xs;
    __device__ __forceinline__ static u32x4 pack8(const f32x4& v0, const f32x4& v1) {
        u32x4 w; w.x = pg8::cvt_pk_bf16(v0[0], v0[1]); w.y = pg8::cvt_pk_bf16(v0[2], v0[3]); w.z = pg8::cvt_pk_bf16(v1[0], v1[1]); w.w = pg8::cvt_pk_bf16(v1[2], v1[3]); return w; }
    __device__ __forceinline__ void operator()(const f32x4 (&acc)[2][2][4][2], const pg8::Unit& u, int wr, int wc, int fr, int fq) const {
        const int pn = u.pn, pm = u.pm; const bool isx = pm < 32;
        const int colw = wc * 32 + 8 * fq;
        const size_t kvrow0 = isx ? (size_t)(pm >> 3) * SKV + (size_t)(pm & 7) * 256 : (size_t)(pm - 32) * SKV + S;
        if (pn < 10) {
            const bool isq = pn < 8;
#pragma unroll
            for (int ai = 0; ai < 2; ++ai)
#pragma unroll
                for (int bj = 0; bj < 2; ++bj)
#pragma unroll
                    for (int m = 0; m < 4; ++m) { const f32x4 v0 = acc[ai][bj][m][0], v1 = acc[ai][bj][m][1];
                        float s = (v0[0] * v0[0] + v0[1] * v0[1]) + (v0[2] * v0[2] + v0[3] * v0[3]) + (v1[0] * v1[0] + v1[1] * v1[1]) + (v1[2] * v1[2] + v1[3] * v1[3]);
                        s += __shfl_xor(s, 16); s += __shfl_xor(s, 32);
                        if (fq == 0) xs[(((wr * 2 + bj) * 128) + ai * 64 + m * 16 + fr) * 4 + wc] = s; }
            asm volatile("s_waitcnt lgkmcnt(0)" ::: "memory"); __builtin_amdgcn_s_barrier(); asm volatile("" ::: "memory");
            const int a_ = wc >> 1, f0 = (wc & 1) * 16 + fq * 4;
            const float* nw = isq ? qnw : knw;
            const f32x4 w0 = *(const f32x4*)(nw + a_ * 64 + f0), w1 = *(const f32x4*)(nw + a_ * 64 + 32 + f0);
#pragma unroll
            for (int ai = 0; ai < 2; ++ai)
#pragma unroll
                for (int m = 0; m < 4; ++m) { const int rt = ai * 128 + wr * 64 + m * 16 + fr;
                    f32x4 cs = (f32x4){1.f, 1.f, 1.f, 1.f}, sn = (f32x4){0.f, 0.f, 0.f, 0.f};
                    if (isx) { const int t = (pm & 7) * 256 + rt, pos = a_ == 0 ? (t >> 6) : (t & 63); cs = *(const f32x4*)(ct + pos * 32 + f0); sn = *(const f32x4*)(st + pos * 32 + f0); }
#pragma unroll
                    for (int bj = 0; bj < 2; ++bj) {
                        const f32x4 p = *(const LAS f32x4*)(xs + (((wr * 2 + bj) * 128) + ai * 64 + m * 16 + fr) * 4);
                        const float rstd = 1.0f / sqrtf(((p[0] + p[1]) + (p[2] + p[3])) * (1.0f / HD) + EPS);
                        const f32x4 x1 = acc[ai][bj][m][0] * rstd * w0, x2 = acc[ai][bj][m][1] * rstd * w1;
                        const f32x4 o1 = x1 * cs - x2 * sn, o2 = x2 * cs + x1 * sn;
                        bf16* dst = isq ? Qb + (size_t)(pm * 256 + rt) * DATT + pn * 256 + bj * 128 + colw
                                        : Kb + (kvrow0 + rt) * DKV + (pn - 8) * 256 + bj * 128 + colw;
                        *(u32x4*)dst = pack8(o1, o2); } }
        } else if (pn < 12) {
#pragma unroll
            for (int ai = 0; ai < 2; ++ai)
#pragma unroll
                for (int m = 0; m < 4; ++m) { const int rt = ai * 128 + wr * 64 + m * 16 + fr;
#pragma unroll
                    for (int bj = 0; bj < 2; ++bj) *(u32x4*)(Vb + (kvrow0 + rt) * DKV + (pn - 10) * 256 + bj * 128 + colw) = pack8(acc[ai][bj][m][0], acc[ai][bj][m][1]); }
        } else if (pn >= 20 && pn < 28) {
#pragma unroll
            for (int ai = 0; ai < 2; ++ai)
#pragma unroll
                for (int m = 0; m < 4; ++m) { const int rt = ai * 128 + wr * 64 + m * 16 + fr;
#pragma unroll
                    for (int bj = 0; bj < 2; ++bj) *(u32x4*)(XL + (size_t)(pm * 256 + rt) * DLRU + (pn - 20) * 256 + bj * 128 + colw) = pack8(acc[ai][bj][m][0], acc[ai][bj][m][1]); }
        } else {
            const bool isga = pn < 20;
#pragma unroll
            for (int ai = 0; ai < 2; ++ai)
#pragma unroll
                for (int m = 0; m < 4; ++m) { const int rt = ai * 128 + wr * 64 + m * 16 + fr;
#pragma unroll
                    for (int bj = 0; bj < 2; ++bj) { f32x4 v0 = acc[ai][bj][m][0], v1 = acc[ai][bj][m][1];
#pragma unroll
                        for (int e = 0; e < 4; ++e) { v0[e] = v0[e] * __builtin_amdgcn_rcpf(1.0f + __expf(-v0[e])); v1[e] = v1[e] * __builtin_amdgcn_rcpf(1.0f + __expf(-v1[e])); }
                        bf16* dst = isga ? GA + (size_t)(pm * 256 + rt) * DATT + (pn - 12) * 256 + bj * 128 + colw
                                         : GL + ((size_t)((((pm >> 3) * NBLK + (pn - 28) * 2 + bj) * 2 + (colw >> 6)) * S) + (pm & 7) * 256 + rt) * 64 + (colw & 63);
                        *(u32x4*)dst = pack8(v0, v1); } }
        }
    }
};
typedef __attribute__((address_space(1))) unsigned gu32;
constexpr int CW_BAR = 4096;
constexpr size_t CTL_ZERO_BYTES = 128 * 1024;
#define XB_TMO      128
#define XB_XCNT(j)  (256  + 64 * (j))
#define XB_XSUB(j)  (1280 + 64 * (j))
#define XB_XGEN(j)  (2304 + 64 * (j))
#define XB_TOP      3328
#define XB_TOPGEN   3392
#define XCD_BAR_WORDS 3456
#define XB_SPIN_CAP (1u << 18)

__device__ __forceinline__ unsigned xb_ld(unsigned* p)              { return __hip_atomic_load(p, __ATOMIC_RELAXED, __HIP_MEMORY_SCOPE_AGENT); }
__device__ __forceinline__ unsigned xb_add(unsigned* p, unsigned v) { return __hip_atomic_fetch_add(p, v, __ATOMIC_RELAXED, __HIP_MEMORY_SCOPE_AGENT); }
__device__ __forceinline__ unsigned xb_xcc_id() { return (unsigned)__builtin_amdgcn_s_getreg((3 << 11) | 20) & 0xFu; }
#define XB_SPIN(cond, bar) do { unsigned _sp = 0; while (cond) { __builtin_amdgcn_s_sleep(1); \
    if ((++_sp & 255u) == 0u) { if (xb_ld(&(bar)[XB_TMO])) break; if (_sp > XB_SPIN_CAP) { atomicAdd(&(bar)[XB_TMO], 1u); break; } } } } while (0)

struct XcdBarrier {
    unsigned* bar; unsigned x;
    volatile LAS unsigned* st;
};

__device__ __forceinline__ XcdBarrier xcd_barrier_post(unsigned* bar, volatile LAS unsigned* st) {
    XcdBarrier b; b.bar = bar; b.x = xb_xcc_id(); b.st = st;
    if (threadIdx.x == 0) (void)xb_add(&bar[XB_XCNT(b.x)], 1u);
    return b;
}
__device__ __forceinline__ void xcd_barrier_complete(unsigned* bar, unsigned x, unsigned& nloc, unsigned& nx) {
    const unsigned G = gridDim.x * gridDim.y * gridDim.z;
    unsigned sum, cnt, mine, sp = 0u;
    for (;;) {
        sum = 0u; cnt = 0u; mine = 0u;
#pragma unroll
        for (unsigned j = 0; j < 16; ++j) { const unsigned c = xb_ld(&bar[XB_XCNT(j)]); sum += c; cnt += (c > 0u) ? 1u : 0u; mine = (j == x) ? c : mine; }
        if (sum == G) break;
        __builtin_amdgcn_s_sleep(1);
        if ((++sp & 255u) == 0u) { if (xb_ld(&bar[XB_TMO])) break; if (sp > XB_SPIN_CAP) { atomicAdd(&bar[XB_TMO], 1u); break; } }
    }
    nloc = mine > 0u ? mine : 1u; nx = cnt > 0u ? cnt : 1u;
}

__device__ __forceinline__ void xcd_barrier(const XcdBarrier& b) {
    asm volatile("s_waitcnt vmcnt(0)" ::: "memory");
    __syncthreads();
    if (threadIdx.x == 0) {
        unsigned* bar = b.bar;
        __builtin_amdgcn_s_waitcnt(0);
        unsigned nloc = b.st[0], nx = b.st[1];
        if (nloc == 0u) { xcd_barrier_complete(bar, b.x, nloc, nx); b.st[0] = nloc; b.st[1] = nx; }
        const unsigned old = xb_add(&bar[XB_XSUB(b.x)], 1u);
        const unsigned gen = old / nloc;
        if (old + 1u == (gen + 1u) * nloc) {
            __builtin_amdgcn_fence(__ATOMIC_RELEASE, "agent");
            asm volatile("s_waitcnt vmcnt(0)" ::: "memory");
            const unsigned og = xb_add(&bar[XB_TOP], 1u);
            const unsigned tg = og / nx;
            if (og + 1u == (tg + 1u) * nx) xb_add(&bar[XB_TOPGEN], 1u);
            else XB_SPIN(xb_ld(&bar[XB_TOPGEN]) == tg, bar);
            __builtin_amdgcn_fence(__ATOMIC_ACQUIRE, "agent");
            xb_add(&bar[XB_XGEN(b.x)], 1u);
            asm volatile("s_waitcnt vmcnt(0)" ::: "memory");
        } else {
            XB_SPIN(xb_ld(&bar[XB_XGEN(b.x)]) == gen, bar);
            __builtin_amdgcn_fence(__ATOMIC_ACQUIRE, "agent");
            asm volatile("s_waitcnt vmcnt(0)" ::: "memory");
        }
    }
    __syncthreads();
}

constexpr int NPHASE = 6;
__global__ void __launch_bounds__(NTHREADS, 2) mk_fwd(Args a) {
    extern __shared__ __attribute__((aligned(16))) unsigned char lds[];
    const int bid = blockIdx.x, nb = gridDim.x;
    const int lo = a.ph_lo, hi = a.ph_hi;
#define IN(k) (lo <= (k) && (k) < hi)
#if MK_ONE_LAUNCH
    volatile LAS unsigned* MISC = (volatile LAS unsigned*)((LAS unsigned char*)lds + MISC_OFF);
    if (threadIdx.x < 64) MISC[threadIdx.x] = 0u;
    __syncthreads();
    const XcdBarrier bar = xcd_barrier_post((unsigned*)(a.ws + WS_CTL) + CW_BAR, MISC + 8);
#define SEAM(k) do { if (IN(k) && IN((k) + 1)) xcd_barrier(bar); } while (0)
#else
#define SEAM(k) do { } while (0)
#endif
    if (IN(0)) { phase_prep(a, (LAS unsigned char*)lds, bid, nb); } SEAM(0);
    const bool flow = MK_ONE_LAUNCH && nb == 256 && IN(1) && IN(2);
    if (IN(1)) { phase_norm(a, (LAS unsigned char*)lds, bid, nb, flow); } if (!flow) SEAM(1);
    if (IN(2)) {
        const bool split = (nb == 256);
        if (split && bid >= nb - NPROD) producer_phase(a, (LAS unsigned char*)lds, bid - (nb - NPROD));
        else {
        pg8::Gemm g{(const pg8::bf16_t*)(a.ws + WS_H), (const pg8::bf16_t*)(a.ws + WS_WIN), MT, DIN, D}; InProjOrder So;
        So.init(split ? nb - NPROD : nb, bid, (const unsigned*)(a.ws + WS_CTL) + CW_TILE, split ? NPROD * NWAVES : 0, flow);
        const float* ctp = (const float*)(a.ws + WS_ROPE);
        EpiInProj E{(bf16*)(a.ws + WS_Q), (bf16*)(a.ws + WS_K), (bf16*)(a.ws + WS_V), (bf16*)(a.ws + WS_GA), (bf16*)(a.ws + WS_XL), (bf16*)(a.ws + WS_GL),
                    a.in[I_QNW], a.in[I_KNW], ctp, ctp + 64 * 32, (LAS float*)((LAS unsigned char*)lds + XS_OFF)};
        pg8::gemm_phase<EpiInProj, InProjOrder, true, true>((PG8_LAS unsigned char*)lds, g, So, E);
        if (!split) { const int rem = 1200 % nb; if (rem == 0) wout_transpose(a, (LAS unsigned char*)lds, bid, nb); else if (bid >= rem) wout_transpose(a, (LAS unsigned char*)lds, bid - rem, nb - rem); }
        }
    } SEAM(2);
    const int vb = (nb % 8 == 0) ? (bid % 8) * (nb / 8) + bid / 8 : bid;
    if (IN(3)) { phase_lru(a, (LAS unsigned char*)lds, vb, nb); __syncthreads(); }
    if (IN(4)) { phase_attn(a, (char*)lds, vb, nb); } SEAM(4);
    if (IN(5)) {
        pg8::Gemm g{(const pg8::bf16_t*)(a.ws + WS_MIX), (const pg8::bf16_t*)(a.ws + WS_WOUT), MX, D, DMIX}; pg8::StaticOrder So; So.init(MX, D, nb, bid);
        { LAS float* ftab = (LAS float*)((LAS unsigned char*)lds + XS_OFF); const float* SSQA = (const float*)(a.ws + WS_SSQA); const float* SSQL = (const float*)(a.ws + WS_SSQL);
          const int t_ = threadIdx.x, r_ = t_ & 255, part = t_ >> 8;
#pragma unroll 1
          for (int i = 0; i < 4; ++i) { pg8::Unit u; if (!So.next(i, u)) break; const size_t row = (size_t)u.pm * 256 + r_; float s = 0.f;
              if (part == 0) {
#pragma unroll
                  for (int j = 0; j < 4; ++j) { const f32x4 q = *(const f32x4*)(SSQA + row * 16 + 4 * j); s += (q[0] + q[1]) + (q[2] + q[3]); }
                  ftab[(i * 256 + r_) * 2] = 1.0f / sqrtf(s * (1.0f / DATT) + EPS); }
              else {
#pragma unroll
                  for (int j = 0; j < 8; ++j) { const f32x4 q = *(const f32x4*)(SSQL + row * 32 + 4 * j); s += (q[0] + q[1]) + (q[2] + q[3]); }
                  ftab[(i * 256 + r_) * 2 + 1] = 1.0f / sqrtf(s * (1.0f / DLRU) + EPS); } }
          __syncthreads(); }
        pg8::EpiResid E{a.in[I_X], a.out, D, (const float*)(a.ws + WS_MOD) + 2 * D, DMOD, S, (const PG8_LAS float*)((PG8_LAS unsigned char*)lds + XS_OFF)};
        pg8::gemm_phase<pg8::EpiResid, pg8::StaticOrder, true, true>((PG8_LAS unsigned char*)lds, g, So, E);
    }
#undef IN
#undef SEAM
}
}

extern "C" void kernel_launch(void* const* d_in, const int* in_sizes, int n_in, void* d_out, int out_size, void* d_ws, size_t ws_size, hipStream_t stream) {
    using namespace mk;
    static int grid = 0;
    if (grid == 0) {
        if (n_in != 20 || in_sizes[0] != MX * D || out_size != MX * D || ws_size < WS_END) { fprintf(stderr, "kernel_launch: unexpected shapes (n_in %d, in0 %d, out %d, ws %zu)\n", n_in, n_in > 0 ? in_sizes[0] : -1, out_size, ws_size); grid = -1; return; }
        int dev = 0, cus = 0, per_cu = 0;
        (void)hipGetDevice(&dev); (void)hipDeviceGetAttribute(&cus, hipDeviceAttributeMultiprocessorCount, dev);
        if (hipFuncSetAttribute((const void*)mk_fwd, hipFuncAttributeMaxDynamicSharedMemorySize, LDS_BYTES) != hipSuccess) { fprintf(stderr, "kernel_launch: hipFuncSetAttribute failed\n"); grid = -1; return; }
        (void)hipOccupancyMaxActiveBlocksPerMultiprocessor(&per_cu, (const void*)mk_fwd, NTHREADS, LDS_BYTES);
        if (per_cu < 1) { fprintf(stderr, "kernel_launch: occupancy query says %d blocks per CU\n", per_cu); per_cu = 1; }
        (void)hipGetLastError();
        grid = cus;
    }
    if (grid < 0) return;
    Args a{};
    for (int i = 0; i < 20; ++i) a.in[i] = (const float*)d_in[i];
    a.out = (float*)d_out; a.ws = (unsigned char*)d_ws;
#if MK_ONE_LAUNCH
    a.ph_lo = 0; a.ph_hi = NPHASE;
    if (hipMemsetAsync((char*)d_ws + WS_CTL, 0, CTL_ZERO_BYTES, stream) != hipSuccess) { fprintf(stderr, "kernel_launch: memset failed\n"); return; }
    hipLaunchKernelGGL(mk_fwd, dim3(grid), dim3(NTHREADS), LDS_BYTES, stream, a);
    const hipError_t le = hipPeekAtLastError();
    if (le != hipSuccess) fprintf(stderr, "kernel_launch: launch failed: %s\n", hipGetErrorName(le));
#else
    for (int p = 0; p < NPHASE; ++p) {
        a.ph_lo = p; a.ph_hi = p + 1;
        hipLaunchKernelGGL(mk_fwd, dim3(grid), dim3(NTHREADS), LDS_BYTES, stream, a);
    }
    const hipError_t le = hipPeekAtLastError();
    if (le != hipSuccess) fprintf(stderr, "kernel_launch: launch failed: %s\n", hipGetErrorName(le));
#endif
}
```
